# Optimizing an MI355X kernel written in HIP

```python
import math
import jax, jax.numpy as jnp
from jax import lax
import numpy as np

D_MODEL = 1024
BATCH = 8
SEQ = 2048
DEPTH = 4
DEC_BATCH = 128
DEC_SEQ = 4
PAST_LEN = 8192
PAGE_SIZE = 128

MIX_WIDTH = D_MODEL
POOL_WIDTH = MIX_WIDTH // 4
HG_WIDTH = MIX_WIDTH // 4
ATT_WIDTH = MIX_WIDTH - POOL_WIDTH - HG_WIDTH
POOL_WINDOWS = (2, 4, 8, 16)
POOL_GROUPS = len(POOL_WINDOWS)
POOL_GW = POOL_WIDTH // POOL_GROUPS
POOL_BUF = max(POOL_WINDOWS) - 1
HG_HEADS = 4
HG_DK = HG_WIDTH // HG_HEADS
HG_DV = HG_WIDTH // HG_HEADS
HG_CHUNK = 16
HEAD_DIM = 64
ATT_HEADS = ATT_WIDTH // HEAD_DIM
KV_HEADS = 2
GQA_GROUP = ATT_HEADS // KV_HEADS
WINDOW = 128
REL_BUCKETS = 32
REL_MAX_DIST = 128
D_FF = 2816
N_MOD = 9
EPS = 1e-6
OFF_POOL = 0
OFF_HQ = OFF_POOL + POOL_WIDTH
OFF_HF = OFF_HQ + HG_WIDTH
OFF_HI = OFF_HF + HG_WIDTH
OFF_HG = OFF_HI + HG_WIDTH
OFF_AQ = OFF_HG + HG_WIDTH
OFF_AK = OFF_AQ + ATT_WIDTH
OFF_AV = OFF_AK + KV_HEADS * HEAD_DIM
IN_WIDTH = OFF_AV + KV_HEADS * HEAD_DIM

kernel_name = 'hybrid_pool_hgrn2_swa_macaron_adaln_step'


def _rmsnorm(x, g):
    xf = x.astype(jnp.float32)
    r = lax.rsqrt(jnp.mean(xf * xf, axis=-1, keepdims=True) + EPS)
    return (xf * r).astype(x.dtype) * g


def _modulate(h, shift, scale):
    return h * (1.0 + scale[:, None, :]) + shift[:, None, :]


def _swiglu(h, wg, wu, wd):
    return (jax.nn.silu(h @ wg) * (h @ wu)) @ wd


def _pool_mixer(u, prefix, pos0, pool_w, pool_scale):
    B, T, _ = u.shape
    P = POOL_BUF
    ext = jnp.concatenate([prefix, u], axis=1).astype(jnp.float32)
    cs = jnp.concatenate([jnp.zeros((B, 1, POOL_WIDTH), jnp.float32), jnp.cumsum(ext, axis=1)], axis=1)
    pos = pos0 + jnp.arange(T)
    means = []
    for gi, w in enumerate(POOL_WINDOWS):
        sl = slice(gi * POOL_GW, (gi + 1) * POOL_GW)
        win_sum = cs[:, P + 1:P + T + 1, sl] - cs[:, P + 1 - w:P + T + 1 - w, sl]
        cnt = jnp.minimum(pos + 1, w).astype(jnp.float32)[None, :, None]
        means.append(win_sum / cnt)
    d = (jnp.concatenate(means, axis=-1) - ext[:, P:]).reshape(B, T, POOL_GROUPS, POOL_GW)
    y = jnp.einsum('btgc,gcd->btgd', d, pool_w.astype(jnp.float32)).reshape(B, T, POOL_WIDTH)
    y = y * pool_scale.astype(jnp.float32)
    return y.astype(u.dtype), ext[:, -P:].astype(u.dtype)


def _hgrn2(q, k, v, logf, S0):
    B, T, H, K = q.shape
    C = HG_CHUNK if T % HG_CHUNK == 0 else T
    n = T // C

    def blk(a):
        return a.reshape(B, n, C, *a.shape[2:]).swapaxes(0, 1)

    q, k, v, logf = blk(q), blk(k), blk(v), blk(logf)
    b = jnp.cumsum(logf, axis=2)
    causal = jnp.tril(jnp.ones((C, C), dtype=bool))
    diff = b[:, :, :, None] - b[:, :, None, :]
    decay = jnp.exp(jnp.where(causal[None, None, :, :, None, None], diff, -jnp.inf))
    A = jnp.einsum('nbthk,nbshk,nbtshk->nbtsh', q, k, decay)
    o_intra = jnp.einsum('nbtsh,nbshv->nbthv', A, v)
    b_last = b[:, :, -1]
    q_in = q * jnp.exp(b)
    k_out = k * jnp.exp(b_last[:, :, None] - b)
    g_last = jnp.exp(b_last)

    def step(S, xs):
        qi, ko, vc, gl = xs
        o = jnp.einsum('bthk,bhkv->bthv', qi, S)
        S = gl[..., None] * S + jnp.einsum('bthk,bthv->bhkv', ko, vc)
        return S, o

    S, o_inter = lax.scan(step, S0, (q_in, k_out, v, g_last))
    o = (o_intra + o_inter).swapaxes(0, 1).reshape(B, T, H, v.shape[-1])
    return o, S


def _t5_bucket(rel):
    n = jnp.maximum(-rel, 0)
    exact = REL_BUCKETS // 2
    nf = jnp.maximum(n, 1).astype(jnp.float32)
    large = exact + (jnp.log(nf / exact) / math.log(REL_MAX_DIST / exact) * (REL_BUCKETS - exact)).astype(jnp.int32)
    large = jnp.minimum(large, REL_BUCKETS - 1)
    return jnp.where(n < exact, n, large)


def _swa_core(q, k, v, qp, kp, sinks, rel_bias):
    N, Tq = qp.shape
    Tk = kp.shape[1]
    logits = jnp.einsum('bnqhgd,bnkhd->bnhgqk', q.astype(jnp.float32), k.astype(jnp.float32)) * (HEAD_DIM ** -0.5)
    rel = kp[:, None, :] - qp[:, :, None]
    bias = rel_bias.astype(jnp.float32)[_t5_bucket(rel)]
    bias = bias.reshape(N, Tq, Tk, KV_HEADS, GQA_GROUP).transpose(0, 3, 4, 1, 2)
    valid = (rel <= 0) & (rel > -WINDOW) & (kp >= 0)[:, None, :]
    logits = jnp.where(valid[None, :, None, None], logits + bias[None], -jnp.inf)
    sink = sinks.astype(jnp.float32).reshape(KV_HEADS, GQA_GROUP)[None, None, :, :, None]
    m = jnp.maximum(jnp.max(logits, axis=-1), sink)
    p = jnp.exp(logits - m[..., None])
    denom = jnp.sum(p, axis=-1) + jnp.exp(sink - m)
    probs = p / denom[..., None]
    return jnp.einsum('bnhgqk,bnkhd->bnqhgd', probs, v.astype(jnp.float32))


def _swa(q, k, v, k_buf, v_buf, pos0, sinks, rel_bias):
    B, T = q.shape[:2]
    P = WINDOW
    k_ext = jnp.concatenate([k_buf, k], axis=1)
    v_ext = jnp.concatenate([v_buf, v], axis=1)
    k_pos = pos0 - P + jnp.arange(P + T)
    q_pos = pos0 + jnp.arange(T)
    if T % WINDOW == 0:
        nb = T // WINDOW
        qb = q.reshape(B, nb, WINDOW, KV_HEADS, GQA_GROUP, HEAD_DIM)
        kb = k_ext.reshape(B, nb + 1, WINDOW, KV_HEADS, HEAD_DIM)
        vb = v_ext.reshape(B, nb + 1, WINDOW, KV_HEADS, HEAD_DIM)
        kband = jnp.concatenate([kb[:, :-1], kb[:, 1:]], axis=2)
        vband = jnp.concatenate([vb[:, :-1], vb[:, 1:]], axis=2)
        qp = q_pos.reshape(nb, WINDOW)
        kpb = k_pos.reshape(nb + 1, WINDOW)
        kp = jnp.concatenate([kpb[:-1], kpb[1:]], axis=1)
    else:
        qb = q.reshape(B, 1, T, KV_HEADS, GQA_GROUP, HEAD_DIM)
        kband = k_ext[:, None]
        vband = v_ext[:, None]
        qp = q_pos[None]
        kp = k_pos[None]
    out = _swa_core(qb, kband, vband, qp, kp, sinks, rel_bias)
    return out.reshape(B, T, ATT_WIDTH), k_ext[:, -P:], v_ext[:, -P:]


def _mixers(h, pool_buf, hg_state, k_buf, v_buf, pos0, lb, w_in, w_out, pool_w, pool_scale, hg_norm, sinks, rel_bias):
    B, T, _ = h.shape
    f32 = jnp.float32
    z = h @ w_in
    y_pool, new_pool = _pool_mixer(z[..., OFF_POOL:OFF_HQ], pool_buf, pos0, pool_w, pool_scale)
    hs = (B, T, HG_HEADS, HG_DK)
    hq = jax.nn.silu(z[..., OFF_HQ:OFF_HF].astype(f32)).reshape(hs)
    f = lb + (1.0 - lb) * jax.nn.sigmoid(z[..., OFF_HF:OFF_HI].astype(f32))
    logf = jnp.log(f).reshape(hs)
    hk = (1.0 - f).reshape(hs)
    hv = z[..., OFF_HI:OFF_HG].astype(f32).reshape(B, T, HG_HEADS, HG_DV)
    o, new_S = _hgrn2(hq, hk, hv, logf, hg_state.astype(f32))
    o = _rmsnorm(o, hg_norm.astype(f32)) * jax.nn.silu(z[..., OFF_HG:OFF_AQ].astype(f32).reshape(B, T, HG_HEADS, HG_DV))
    y_hg = o.reshape(B, T, HG_WIDTH).astype(h.dtype)
    aq = z[..., OFF_AQ:OFF_AK].reshape(B, T, ATT_HEADS, HEAD_DIM)
    ak = z[..., OFF_AK:OFF_AV].reshape(B, T, KV_HEADS, HEAD_DIM)
    av = z[..., OFF_AV:IN_WIDTH].reshape(B, T, KV_HEADS, HEAD_DIM)
    y_att, new_k, new_v = _swa(aq, ak, av, k_buf, v_buf, pos0, sinks, rel_bias)
    y = jnp.concatenate([y_pool, y_hg, y_att.astype(h.dtype)], axis=-1) @ w_out
    return y, new_pool, new_S.astype(hg_state.dtype), new_k, new_v


def _layer(x, c, pool_buf, hg_state, k_buf, v_buf, pos0, lb, rel_bias,
           n1, n2, n3, w_mod, b_mod, f1g, f1u, f1d, w_in, w_out, pool_w, pool_scale,
           hg_norm, sinks, f2g, f2u, f2d):
    B = x.shape[0]
    mod = (jax.nn.silu(c) @ w_mod + b_mod).reshape(B, N_MOD, D_MODEL)
    h = _modulate(_rmsnorm(x, n1), mod[:, 0], mod[:, 1])
    x = x + 0.5 * mod[:, 2][:, None, :] * _swiglu(h, f1g, f1u, f1d)
    h = _modulate(_rmsnorm(x, n2), mod[:, 3], mod[:, 4])
    y, new_pool, new_S, new_k, new_v = _mixers(h, pool_buf, hg_state, k_buf, v_buf, pos0, lb,
                                                w_in, w_out, pool_w, pool_scale, hg_norm, sinks, rel_bias)
    x = x + mod[:, 5][:, None, :] * y
    h = _modulate(_rmsnorm(x, n3), mod[:, 6], mod[:, 7])
    x = x + 0.5 * mod[:, 8][:, None, :] * _swiglu(h, f2g, f2u, f2d)
    return x, new_pool, new_S, new_k, new_v


def setup_inputs(seed: int = 0) -> dict:
    key = jax.random.key(seed)
    ks = jax.random.split(key, 32)
    f32 = jnp.float32
    D = D_MODEL

    def nrm(k, shape, scale):
        return jax.random.normal(k, shape, f32) * scale

    def gain(k, shape):
        return 1.0 + 0.05 * jax.random.normal(k, shape, f32)

    return {
        'x_prompt': nrm(ks[0], (BATCH, SEQ, D), 1.0),
        'x_sample': nrm(ks[1], (DEC_BATCH, DEC_SEQ, D), 1.0),
        'c_prompt': nrm(ks[2], (BATCH, D), 1.0),
        'c_sample': nrm(ks[3], (DEC_BATCH, D), 1.0),
        'state_pool': nrm(ks[4], (DEPTH, DEC_BATCH, POOL_BUF, POOL_WIDTH), 1.0),
        'state_hgrn': nrm(ks[5], (DEPTH, DEC_BATCH, HG_HEADS, HG_DK, HG_DV), 0.5),
        'cache_k_win': nrm(ks[6], (DEPTH, DEC_BATCH, WINDOW, KV_HEADS, HEAD_DIM), 1.0),
        'cache_v_win': nrm(ks[7], (DEPTH, DEC_BATCH, WINDOW, KV_HEADS, HEAD_DIM), 1.0),
        'norm_ffn1': gain(ks[8], (DEPTH, D)),
        'norm_mix': gain(ks[9], (DEPTH, D)),
        'norm_ffn2': gain(ks[10], (DEPTH, D)),
        'w_mod': nrm(ks[11], (DEPTH, D, N_MOD * D), D ** -0.5),
        'b_mod': nrm(ks[12], (DEPTH, N_MOD * D), 0.02),
        'ffn1_w_gate': nrm(ks[13], (DEPTH, D, D_FF), D ** -0.5),
        'ffn1_w_up': nrm(ks[14], (DEPTH, D, D_FF), D ** -0.5),
        'ffn1_w_down': nrm(ks[15], (DEPTH, D_FF, D), D_FF ** -0.5),
        'w_in': nrm(ks[16], (DEPTH, D, IN_WIDTH), D ** -0.5),
        'w_out': nrm(ks[17], (DEPTH, MIX_WIDTH, D), MIX_WIDTH ** -0.5),
        'pool_w': nrm(ks[18], (DEPTH, POOL_GROUPS, POOL_GW, POOL_GW), POOL_GW ** -0.5),
        'pool_scale': gain(ks[19], (DEPTH, POOL_WIDTH)),
        'hgrn_lower': nrm(ks[20], (DEPTH, HG_WIDTH), 0.1),
        'hgrn_norm': gain(ks[21], (DEPTH, HG_DV)),
        'attn_sinks': nrm(ks[22], (DEPTH, ATT_HEADS), 0.5),
        'rel_bias': nrm(ks[23], (REL_BUCKETS, ATT_HEADS), 0.5),
        'ffn2_w_gate': nrm(ks[24], (DEPTH, D, D_FF), D ** -0.5),
        'ffn2_w_up': nrm(ks[25], (DEPTH, D, D_FF), D ** -0.5),
        'ffn2_w_down': nrm(ks[26], (DEPTH, D_FF, D), D_FF ** -0.5),
        'norm_final': gain(ks[27], (D,)),
    }


def reference(x_prompt, x_sample, c_prompt, c_sample, state_pool, state_hgrn, cache_k_win, cache_v_win,
              norm_ffn1, norm_mix, norm_ffn2, w_mod, b_mod, ffn1_w_gate, ffn1_w_up, ffn1_w_down,
              w_in, w_out, pool_w, pool_scale, hgrn_lower, hgrn_norm, attn_sinks, rel_bias,
              ffn2_w_gate, ffn2_w_up, ffn2_w_down, norm_final):
    lb_sm = jax.nn.softmax(hgrn_lower.astype(jnp.float32), axis=0)
    lbs = jnp.cumsum(lb_sm, axis=0) - lb_sm[0]

    xp, xs = x_prompt, x_sample
    dt = x_prompt.dtype
    zp_pool = jnp.zeros((BATCH, POOL_BUF, POOL_WIDTH), dt)
    zp_hg = jnp.zeros((BATCH, HG_HEADS, HG_DK, HG_DV), dt)
    zp_kv = jnp.zeros((BATCH, WINDOW, KV_HEADS, HEAD_DIM), dt)
    pool_p, hg_p, k_p, v_p = [], [], [], []
    pool_s, hg_s, k_s, v_s = [], [], [], []
    for l in range(DEPTH):
        w = (norm_ffn1[l], norm_mix[l], norm_ffn2[l], w_mod[l], b_mod[l],
             ffn1_w_gate[l], ffn1_w_up[l], ffn1_w_down[l], w_in[l], w_out[l],
             pool_w[l], pool_scale[l], hgrn_norm[l], attn_sinks[l],
             ffn2_w_gate[l], ffn2_w_up[l], ffn2_w_down[l])
        xp, a, b, c, d = _layer(xp, c_prompt, zp_pool, zp_hg, zp_kv, zp_kv, 0, lbs[l], rel_bias, *w)
        pool_p.append(a); hg_p.append(b); k_p.append(c); v_p.append(d)
        xs, a, b, c, d = _layer(xs, c_sample, state_pool[l], state_hgrn[l], cache_k_win[l], cache_v_win[l],
                                PAST_LEN, lbs[l], rel_bias, *w)
        pool_s.append(a); hg_s.append(b); k_s.append(c); v_s.append(d)

    y_prompt = _rmsnorm(xp, norm_final)
    y_sample = _rmsnorm(xs, norm_final)
    new_pool_p = jnp.stack(pool_p)
    new_hgrn_p = jnp.stack(hg_p)
    new_k_p = jnp.stack(k_p)
    new_v_p = jnp.stack(v_p)
    new_pool_s = jnp.stack(pool_s)
    new_hgrn_s = jnp.stack(hg_s)
    new_k_s = jnp.stack(k_s)
    new_v_s = jnp.stack(v_s)
    return (y_prompt, y_sample, new_pool_p, new_hgrn_p, new_k_p, new_v_p, new_pool_s, new_hgrn_s, new_k_s, new_v_s)
```

```cpp
#include <hip/hip_runtime.h>
#include <hip/hip_cooperative_groups.h>
#include <cstdio>
#include <cstdint>
namespace cg = cooperative_groups;
namespace pg8 {
#define PG8_LAS __attribute__((address_space(3)))
typedef unsigned short bf16_t;
typedef short bf16x8 __attribute__((ext_vector_type(8)));
typedef float f32x4 __attribute__((ext_vector_type(4)));
typedef unsigned u32x4 __attribute__((ext_vector_type(4)));
constexpr int BM = 256, BK = 64, HALF = 128, HTB = HALF * BK * 2  , STAGE_BYTES = 8 * HTB, NXCD = 8, WGM = 8;

__host__ __device__ __forceinline__ int lds_byte(int r, int c) { const int st = (r >> 4) * 2 + (c >> 5), rr = r & 15, cc = c & 31, ob = rr * 64 + cc * 2; return st * 1024 + (ob ^ (((ob >> 9) & 1) << 5)); }
__host__ __device__ __forceinline__ void stage_rc(int b, int& R, int& C) { const int st = b / 1024, sb = b % 1024, swz = sb ^ (((sb >> 9) & 1) << 5); R = (st >> 1) * 16 + swz / 64; C = (st & 1) * 32 + (swz % 64) / 2; }
__host__ __device__ __forceinline__ int perm32(int rho) { const int n = rho >> 4, i = rho & 15; return 8 * (i >> 2) + 4 * n + (i & 3); }

struct Unit { int pm, pn; };
struct Gemm { const bf16_t* A; const bf16_t* Bt; int M, N, K; };

struct StaticOrder {
    int nM, nN, nwg, G, c;
    __host__ __device__ void init(int M, int N, int G_, int c_) { nM = M / BM; nN = N / BM; nwg = nM * nN; G = G_; c = c_; }
    __host__ __device__ bool next(int i, Unit& u) const {
        const long L = (long)i * G + c; if (L >= nwg) return false;
        int wgid = (int)L; { const int q = nwg / NXCD, r = nwg % NXCD, xcd = wgid % NXCD, off = wgid / NXCD; wgid = (xcd < r ? xcd * (q + 1) : r * (q + 1) + (xcd - r) * q) + off; }
        const int nig = WGM * nN, gid = wgid / nig, fm = gid * WGM, gsz = (nM - fm) < WGM ? (nM - fm) : WGM;
        u.pm = fm + ((wgid % nig) % gsz); u.pn = (wgid % nig) / gsz; return true;
    }
    __device__ __forceinline__ void a_ready(const Unit&) const {}
    __device__ __forceinline__ void done(const Unit&) const {}
};

__device__ __forceinline__ unsigned cvt_pk_bf16(float lo, float hi) { unsigned r; asm volatile("v_cvt_pk_bf16_f32 %0, %1, %2" : "=v"(r) : "v"(lo), "v"(hi)); return r; }
typedef float f32x2 __attribute__((ext_vector_type(2)));
__device__ __forceinline__ f32x2 gelu_pk(f32x2 v) {
    const f32x2 av = __builtin_elementwise_abs(v), d = av * 0.2316418882f + 1.0f;
    f32x2 t; t.x = __builtin_amdgcn_rcpf(d.x); t.y = __builtin_amdgcn_rcpf(d.y);
    f32x2 q = t * 0.5307027145f + (-0.7265760135f); q = q * t + 0.7107068705f; q = q * t + (-0.142248368f); q = q * t + 0.127414796f; q = q * t;
    const f32x2 s = (v * v) * (-0.72134752044f);
    f32x2 e; e.x = __builtin_amdgcn_exp2f(s.x); e.y = __builtin_amdgcn_exp2f(s.y);
    const f32x2 m = v * (q * e), r = v - m;
    f32x2 o; o.x = v.x < 0.f ? m.x : r.x; o.y = v.y < 0.f ? m.y : r.y; return o;
}

template <int ACT  > struct EpiBf16 {
    static constexpr bool PERM = true, AFTER_DRAIN = false; static_assert(ACT == 0 || ACT == 1, "EpiBf16: ACT is 0 (none) or 1 (gelu_pk)");
    bf16_t* O; int ldc; const float* bias; int split_cols; size_t split_stride; float scale0;
    __device__ __forceinline__ void operator()(const f32x4 (&acc)[2][2][4][2], const Unit& u, int wr, int wc, int fr, int fq) const {
        const int row0 = u.pm * BM + wr * 64 + fr; int colt = u.pn * BM; bf16_t* base = O;
        float sc = 1.f; if (split_cols) { const int t = colt / split_cols; base += (size_t)t * split_stride; colt -= t * split_cols; if (t == 0) sc = scale0; }
        const int col0 = colt + wc * 32 + 8 * fq, bcol0 = u.pn * BM + wc * 32 + 8 * fq;
        f32x4 bv[2][2];
#pragma unroll
        for (int bj = 0; bj < 2; ++bj)
#pragma unroll
            for (int n = 0; n < 2; ++n) bv[bj][n] = bias ? *(const f32x4*)(bias + bcol0 + bj * HALF + 4 * n) : (f32x4){0.f, 0.f, 0.f, 0.f};
#pragma unroll
        for (int ai = 0; ai < 2; ++ai)
#pragma unroll
            for (int m = 0; m < 4; ++m) { bf16_t* rowp = base + (size_t)(row0 + ai * HALF + m * 16) * ldc + col0;
#pragma unroll
                for (int bj = 0; bj < 2; ++bj) { f32x4 v0 = acc[ai][bj][m][0] + bv[bj][0], v1 = acc[ai][bj][m][1] + bv[bj][1];
                    if (ACT == 1) { f32x2 a = gelu_pk((f32x2){v0[0], v0[1]}), b = gelu_pk((f32x2){v0[2], v0[3]}), c = gelu_pk((f32x2){v1[0], v1[1]}), d = gelu_pk((f32x2){v1[2], v1[3]});
                        v0 = (f32x4){a.x, a.y, b.x, b.y}; v1 = (f32x4){c.x, c.y, d.x, d.y}; }
                    v0 = v0 * sc; v1 = v1 * sc; u32x4 w; w.x = cvt_pk_bf16(v0[0], v0[1]); w.y = cvt_pk_bf16(v0[2], v0[3]); w.z = cvt_pk_bf16(v1[0], v1[1]); w.w = cvt_pk_bf16(v1[2], v1[3]);
                    *(u32x4*)(rowp + bj * HALF) = w; } }
    }
};
__device__ __forceinline__ float silu_fast(float x) { return x * __builtin_amdgcn_rcpf(1.0f + __expf(-x)); }
__device__ __forceinline__ int row_batch(int row) { return row < 16384 ? (row >> 11) : 8 + ((row - 16384) >> 2); }
struct EpiSwiGLU {
    static constexpr bool PERM = true, AFTER_DRAIN = false;
    bf16_t* O; int ldc;
    __device__ __forceinline__ void operator()(const f32x4 (&acc)[2][2][4][2], const Unit& u, int wr, int wc, int fr, int fq) const {
        const int row0 = u.pm * BM + wr * 64 + fr; const int col0 = u.pn * HALF + wc * 32 + 8 * fq;
#pragma unroll
        for (int ai = 0; ai < 2; ++ai)
#pragma unroll
            for (int m = 0; m < 4; ++m) { bf16_t* rowp = O + (size_t)(row0 + ai * HALF + m * 16) * ldc + col0;
                const f32x4 g0 = acc[ai][0][m][0], g1 = acc[ai][0][m][1], u0 = acc[ai][1][m][0], u1 = acc[ai][1][m][1];
                u32x4 w; w.x = cvt_pk_bf16(silu_fast(g0[0]) * u0[0], silu_fast(g0[1]) * u0[1]); w.y = cvt_pk_bf16(silu_fast(g0[2]) * u0[2], silu_fast(g0[3]) * u0[3]);
                w.z = cvt_pk_bf16(silu_fast(g1[0]) * u1[0], silu_fast(g1[1]) * u1[1]); w.w = cvt_pk_bf16(silu_fast(g1[2]) * u1[2], silu_fast(g1[3]) * u1[3]);
                *(u32x4*)rowp = w; }
    }
};
struct EpiResid {
    static constexpr bool PERM = false, AFTER_DRAIN = false;
    float* X; const float* Xin; const float* gate; int gpitch; float coef;
    __device__ __forceinline__ void operator()(const f32x4 (&acc)[2][2][4][2], const Unit& u, int wr, int wc, int fr, int fq) const {
        const int col0 = u.pn * BM + wc * 32 + 4 * fq; const float* gp = gate + (size_t)row_batch(u.pm * BM) * gpitch + col0;
        f32x4 gv[2][2];
#pragma unroll
        for (int bj = 0; bj < 2; ++bj)
#pragma unroll
            for (int n = 0; n < 2; ++n) gv[bj][n] = *(const f32x4*)(gp + bj * HALF + n * 16) * coef;
#pragma unroll
        for (int ai = 0; ai < 2; ++ai) { const size_t r0 = (size_t)(u.pm * BM + ai * HALF + wr * 64 + fr) * 1024 + col0; f32x4 xv[4][2][2];
#pragma unroll
            for (int m = 0; m < 4; ++m)
#pragma unroll
                for (int bj = 0; bj < 2; ++bj)
#pragma unroll
                    for (int n = 0; n < 2; ++n) xv[m][bj][n] = *(const f32x4*)(Xin + r0 + (size_t)m * 16 * 1024 + bj * HALF + n * 16);
#pragma unroll
            for (int m = 0; m < 4; ++m)
#pragma unroll
                for (int bj = 0; bj < 2; ++bj)
#pragma unroll
                    for (int n = 0; n < 2; ++n) *(f32x4*)(X + r0 + (size_t)m * 16 * 1024 + bj * HALF + n * 16) = xv[m][bj][n] + gv[bj][n] * acc[ai][bj][m][n]; }
    }
};
struct EpiF32Bias {
    static constexpr bool PERM = false, AFTER_DRAIN = false;
    float* O; int ldc; const float* bias;
    __device__ __forceinline__ void operator()(const f32x4 (&acc)[2][2][4][2], const Unit& u, int wr, int wc, int fr, int fq) const {
        const int col0 = u.pn * BM + wc * 32 + 4 * fq;
#pragma unroll
        for (int ai = 0; ai < 2; ++ai)
#pragma unroll
            for (int m = 0; m < 4; ++m) { const int row = u.pm * BM + ai * HALF + wr * 64 + m * 16 + fr; float* op = O + (size_t)row * ldc + col0;
#pragma unroll
                for (int bj = 0; bj < 2; ++bj)
#pragma unroll
                    for (int n = 0; n < 2; ++n) { const f32x4 b4 = *(const f32x4*)(bias + col0 + bj * HALF + n * 16); *(f32x4*)(op + bj * HALF + n * 16) = acc[ai][bj][m][n] + b4; } }
    }
};
template <class Epi, class Sched, bool ALIGN_EPI = false, bool SP2 = false>
__device__ __forceinline__ void gemm_phase(PG8_LAS unsigned char* lds, const Gemm g, const Sched& S, const Epi& E) {
    int tid_ = threadIdx.x; asm volatile("" : "+v"(tid_)); const int tid = tid_, wid = __builtin_amdgcn_readfirstlane(tid >> 6), lane = tid & 63, wr = wid >> 2, wc = wid & 3, fr = lane & 15, fq = lane >> 4;
    const int K = g.K, nt = K / BK;
    unsigned voffA[2], voffB[2];
#pragma unroll
    for (int i = 0; i < 2; ++i) { int R, C; stage_rc(tid * 16 + i * 8192, R, C); const int Rb = Epi::PERM ? ((R & ~31) + perm32(R & 31)) : R;
        voffA[i] = (unsigned)(R * K + C) * 2u; voffB[i] = (unsigned)(Rb * K + C) * 2u; }
    const size_t kstep = (size_t)(BK * 2);
    const size_t hstep = (size_t)HALF * K * 2;
    const size_t tstep = 2 * hstep;
    const unsigned ldsw = (unsigned)wid * 1024u;
    const int aoff = lds_byte(wr * 64 + fr, fq * 8), boff = lds_byte(wc * 32 + fr, fq * 8);
#define PG8_SA(b, h) (((b) * 2 + (h)) * HTB)
#define PG8_SB(b, h) ((4 + (b) * 2 + (h)) * HTB)
#define PG8_STAGE(bufoff, gbase, voff) do { _Pragma("unroll") for (int _i = 0; _i < 2; ++_i) \
        __builtin_amdgcn_global_load_lds((const unsigned*)((const char*)(gbase) + (voff)[_i]), (PG8_LAS unsigned*)(lds + (bufoff) + ldsw + _i * 8192), 16, 0, 0); } while (0)
#define PG8_LDA(dst, b, h) do { _Pragma("unroll") for (int m = 0; m < 4; ++m) _Pragma("unroll") for (int k = 0; k < 2; ++k) dst[m][k] = *(const PG8_LAS bf16x8*)(lds + PG8_SA(b, h) + aoff + m * 2048 + k * 1024); } while (0)
#define PG8_LDB(dst, b, h) do { _Pragma("unroll") for (int n = 0; n < 2; ++n) _Pragma("unroll") for (int k = 0; k < 2; ++k) dst[n][k] = *(const PG8_LAS bf16x8*)(lds + PG8_SB(b, h) + boff + n * 2048 + k * 1024); } while (0)
#define PG8_MMA(ai, bj, At, Bt) do { __builtin_amdgcn_s_setprio(1); _Pragma("unroll") for (int m = 0; m < 4; ++m) _Pragma("unroll") for (int n = 0; n < 2; ++n) _Pragma("unroll") for (int k = 0; k < 2; ++k) \
        acc[ai][bj][m][n] = __builtin_amdgcn_mfma_f32_16x16x32_bf16(Bt[n][k], At[m][k], acc[ai][bj][m][n], 0, 0, 0); __builtin_amdgcn_s_setprio(0); } while (0)
#define PG8_WAIT_V(n) asm volatile("s_waitcnt vmcnt(" #n ")" ::: "memory")
#define PG8_WAIT_L(n) asm volatile("s_waitcnt lgkmcnt(" #n ")" ::: "memory")
#define PG8_BAR __builtin_amdgcn_s_barrier()
#define PG8_SCHED __builtin_amdgcn_sched_barrier(0)
    Unit cur, nxt; int ui = 0;
    if (!S.next(0, cur)) return;
    f32x4 acc[2][2][4][2];
#pragma unroll
    for (int a = 0; a < 2; ++a)
#pragma unroll
        for (int b = 0; b < 2; ++b)
#pragma unroll
            for (int m = 0; m < 4; ++m)
#pragma unroll
                for (int n = 0; n < 2; ++n) acc[a][b][m][n] = (f32x4){0.f, 0.f, 0.f, 0.f};
    bf16x8 At[4][2], B0[2][2], B1[2][2];
    const char* cA = (const char*)g.A + (size_t)cur.pm * tstep; const char* cB = (const char*)g.Bt + (size_t)cur.pn * tstep;
    S.a_ready(cur);
    if constexpr (SP2) {
        PG8_STAGE(PG8_SB(0, 0), cB, voffB); PG8_STAGE(PG8_SB(0, 1), cB + hstep, voffB); PG8_STAGE(PG8_SA(0, 0), cA, voffA); PG8_STAGE(PG8_SA(0, 1), cA + hstep, voffA);
        if (wr == 1) PG8_BAR;
        PG8_WAIT_V(2); PG8_BAR;
        PG8_STAGE(PG8_SB(1, 0), cB + kstep, voffB); PG8_STAGE(PG8_SA(1, 0), cA + kstep, voffA); PG8_STAGE(PG8_SB(1, 1), cB + hstep + kstep, voffB);
        PG8_WAIT_V(6); PG8_BAR;
    } else {
        PG8_STAGE(PG8_SB(0, 0), cB, voffB); PG8_STAGE(PG8_SA(0, 0), cA, voffA); PG8_STAGE(PG8_SB(0, 1), cB + hstep, voffB); PG8_STAGE(PG8_SA(0, 1), cA + hstep, voffA);
        if (wr == 1) PG8_BAR;
        PG8_WAIT_V(4); PG8_BAR;
        PG8_STAGE(PG8_SB(1, 0), cB + kstep, voffB); PG8_STAGE(PG8_SA(1, 0), cA + kstep, voffA); PG8_STAGE(PG8_SB(1, 1), cB + hstep + kstep, voffB);
        PG8_WAIT_V(6); PG8_BAR;
    }
    for (;;) {
        const bool has_next = S.next(ui + 1, nxt);
        const char* nA = has_next ? (const char*)g.A + (size_t)nxt.pm * tstep : cA; const char* nB = has_next ? (const char*)g.Bt + (size_t)nxt.pn * tstep : cB;
        for (int t = 0; t < nt; t += 2) {
            const bool last = (t == nt - 2);
            const char* a1 = cA + (size_t)(t + 1) * kstep;
            const char* a2 = last ? nA : cA + (size_t)(t + 2) * kstep; const char* b2 = last ? nB : cB + (size_t)(t + 2) * kstep;
            const char* a3 = a2 + kstep; const char* b3 = b2 + kstep;
            if (last && has_next) S.a_ready(nxt);
            if constexpr (SP2) {
            PG8_LDB(B0, 0, 0); PG8_LDB(B1, 0, 1); PG8_SCHED; PG8_LDA(At, 0, 0); PG8_STAGE(PG8_SA(1, 1), a1 + hstep, voffA);
            PG8_WAIT_V(8); PG8_WAIT_L(0); PG8_BAR; PG8_MMA(0, 0, At, B0); PG8_MMA(0, 1, At, B1); PG8_BAR; PG8_SCHED;
            PG8_LDA(At, 0, 1); PG8_STAGE(PG8_SB(0, 0), b2, voffB); PG8_STAGE(PG8_SB(0, 1), b2 + hstep, voffB); PG8_STAGE(PG8_SA(0, 0), a2, voffA);
            PG8_WAIT_V(8); PG8_WAIT_L(0); PG8_BAR; PG8_MMA(1, 0, At, B0); PG8_MMA(1, 1, At, B1); PG8_BAR; PG8_SCHED;
            PG8_LDB(B0, 1, 0); PG8_LDB(B1, 1, 1); PG8_SCHED; PG8_LDA(At, 1, 0); PG8_STAGE(PG8_SA(0, 1), a2 + hstep, voffA);
            PG8_WAIT_V(8); PG8_WAIT_L(0); PG8_BAR; PG8_MMA(0, 0, At, B0); PG8_MMA(0, 1, At, B1); PG8_BAR; PG8_SCHED;
            PG8_LDA(At, 1, 1); PG8_STAGE(PG8_SB(1, 0), b3, voffB); PG8_STAGE(PG8_SB(1, 1), b3 + hstep, voffB); PG8_STAGE(PG8_SA(1, 0), a3, voffA);
            PG8_WAIT_V(8); PG8_WAIT_L(0); PG8_BAR; PG8_MMA(1, 0, At, B0); PG8_MMA(1, 1, At, B1); PG8_BAR; PG8_SCHED;
            } else {
            PG8_LDB(B0, 0, 0); PG8_SCHED; PG8_LDA(At, 0, 0); PG8_STAGE(PG8_SA(1, 1), a1 + hstep, voffA);
            PG8_WAIT_L(8); PG8_BAR; PG8_WAIT_L(0); PG8_MMA(0, 0, At, B0); PG8_BAR; PG8_SCHED;
            PG8_LDB(B1, 0, 1); PG8_STAGE(PG8_SB(0, 0), b2, voffB);
            PG8_BAR; PG8_WAIT_L(0); PG8_MMA(0, 1, At, B1); PG8_BAR;
            PG8_LDA(At, 0, 1); PG8_STAGE(PG8_SA(0, 0), a2, voffA);
            PG8_BAR; PG8_WAIT_L(0); PG8_MMA(1, 0, At, B0); PG8_BAR; PG8_SCHED;
            PG8_STAGE(PG8_SB(0, 1), b2 + hstep, voffB);
            PG8_WAIT_V(6); PG8_BAR; PG8_MMA(1, 1, At, B1); PG8_BAR;
            PG8_LDB(B0, 1, 0); PG8_SCHED; PG8_LDA(At, 1, 0); PG8_STAGE(PG8_SA(0, 1), a2 + hstep, voffA);
            PG8_WAIT_L(8); PG8_BAR; PG8_WAIT_L(0); PG8_MMA(0, 0, At, B0); PG8_BAR; PG8_SCHED;
            PG8_LDB(B1, 1, 1); PG8_STAGE(PG8_SB(1, 0), b3, voffB);
            PG8_BAR; PG8_WAIT_L(0); PG8_MMA(0, 1, At, B1); PG8_BAR;
            PG8_LDA(At, 1, 1); PG8_STAGE(PG8_SA(1, 0), a3, voffA);
            PG8_BAR; PG8_WAIT_L(0); PG8_MMA(1, 0, At, B0); PG8_BAR; PG8_SCHED;
            PG8_STAGE(PG8_SB(1, 1), b3 + hstep, voffB);
            PG8_WAIT_V(6); PG8_BAR; PG8_MMA(1, 1, At, B1); PG8_BAR;
            }
        }
        if constexpr (ALIGN_EPI) { if (wr == 0) PG8_BAR; }
        if constexpr (!Epi::AFTER_DRAIN) { E(acc, cur, wr, wc, fr, fq); S.done(cur); }
        if (!has_next) break;
#pragma unroll
        for (int a = 0; a < 2; ++a)
#pragma unroll
            for (int b = 0; b < 2; ++b)
#pragma unroll
                for (int m = 0; m < 4; ++m)
#pragma unroll
                    for (int n = 0; n < 2; ++n) acc[a][b][m][n] = (f32x4){0.f, 0.f, 0.f, 0.f};
        cur = nxt; cA = nA; cB = nB; ++ui;
        if constexpr (ALIGN_EPI) { if (wr == 1) PG8_BAR; }
    }
    PG8_WAIT_V(0);
    if constexpr (!ALIGN_EPI) { if (wr == 0) PG8_BAR; }
    PG8_BAR;
    if constexpr (Epi::AFTER_DRAIN) { E.fused(acc, cur, wr, wc, fr, fq, lds, wid, lane); S.done(cur); }
#undef PG8_SA
#undef PG8_SB
#undef PG8_STAGE
#undef PG8_LDA
#undef PG8_LDB
#undef PG8_MMA
#undef PG8_WAIT_V
#undef PG8_WAIT_L
#undef PG8_BAR
#undef PG8_SCHED
}
}
#ifndef MIXPROBE
#define MIXPROBE 0
#endif
#ifndef MK_MULTI
#define MK_MULTI 0
#endif
#define LAS __attribute__((address_space(3)))
typedef unsigned short bf16_t;
typedef short bf16x8 __attribute__((ext_vector_type(8)));
typedef float f32x4 __attribute__((ext_vector_type(4)));
typedef float f32x16 __attribute__((ext_vector_type(16)));
typedef unsigned u32x4 __attribute__((ext_vector_type(4)));
typedef unsigned u32x2 __attribute__((ext_vector_type(2)));
typedef float f32x2 __attribute__((ext_vector_type(2)));
#define LDS_WAIT() asm volatile("s_waitcnt lgkmcnt(0)" ::: "memory")

constexpr int D = 1024, TP = 2048, MP = 16384, MS = 512, MT = MP + MS;
constexpr int FF = 2816, INW = 2048, NMODL = 9216, NMOD = 4 * NMODL, DEPTH = 4;
constexpr int OFF_HQ = 256, OFF_HF = 512, OFF_HI = 768, OFF_HG = 1024, OFF_AQ = 1280, OFF_AK = 1792, OFF_AV = 1920;
constexpr int HL = 32, HNC = TP / HL;
constexpr float EPS = 1e-6f;
constexpr int LDS_BYTES = 147456;
constexpr size_t O_Y = 0, O_POOLP = 17301504, O_HGP = 17424384, O_KP = 17948672, O_VP = 18472960, O_POOLS = 18997248, O_HGS = 20963328, O_KS = 29351936, O_VS = 37740544, O_END = 46129152;
constexpr size_t MiB = 1u << 20;
constexpr size_t WS_LBS = 1 * MiB, WS_SC = 2 * MiB, WS_WMOD = 4 * MiB, WS_WL = 76 * MiB, WL_STRIDE = 39 * MiB;
constexpr size_t WL_GU1 = 0, WL_D1 = 11 * MiB, WL_WIN = 16 * MiB + MiB / 2, WL_WOUT = 20 * MiB + MiB / 2, WL_GU2 = 22 * MiB + MiB / 2, WL_D2 = 33 * MiB + MiB / 2;
constexpr size_t WS_MOD = 232 * MiB, WS_H = 268 * MiB, WS_G = 301 * MiB, WS_Z = 301 * MiB, WS_Y = 367 * MiB, WS_HU = 400 * MiB, WS_HP = 432 * MiB, WS_END = 434 * MiB;
static_assert(WL_D2 + (size_t)D * FF * 2 <= WL_STRIDE && WS_WL + 4 * WL_STRIDE <= WS_MOD && WS_MOD + (size_t)256 * NMOD * 4 <= WS_H && WS_H + (size_t)MT * D * 2 <= WS_G, "ws map");
static_assert(WS_G + (size_t)MT * FF * 2 <= WS_HU && WS_Z + (size_t)MT * INW * 2 <= WS_Y && WS_Y + (size_t)MT * D * 2 <= WS_HU && WS_HU + (size_t)32 * HNC * 4096 * 4 <= WS_HP, "ws map 2");

__constant__ unsigned char c_bucket[128] = {0, 1, 2, 3, 4, 5, 6, 7, 8, 9, 10, 11, 12, 13, 14, 15, 16, 16, 16, 17, 17, 18, 18, 18, 19, 19, 19, 20, 20, 20, 20, 21, 21, 21, 21, 22, 22, 22, 22, 22, 23, 23, 23, 23, 23, 23, 24, 24, 24, 24, 24, 24, 25, 25, 25, 25, 25, 25, 25, 26, 26, 26, 26, 26, 26, 26, 26, 27, 27, 27, 27, 27, 27, 27, 27, 27, 27, 28, 28, 28, 28, 28, 28, 28, 28, 28, 28, 29, 29, 29, 29, 29, 29, 29, 29, 29, 29, 29, 29, 30, 30, 30, 30, 30, 30, 30, 30, 30, 30, 30, 30, 30, 30, 31, 31, 31, 31, 31, 31, 31, 31, 31, 31, 31, 31, 31, 31, 31};

__device__ __forceinline__ unsigned pk2(float lo, float hi) { unsigned r; asm("v_cvt_pk_bf16_f32 %0, %1, %2" : "=v"(r) : "v"(lo), "v"(hi)); return r; }
__device__ __forceinline__ unsigned f2bf(float f) { return pk2(f, 0.0f) & 0xffffu; }
__device__ __forceinline__ float bf2f(unsigned u) { return __builtin_bit_cast(float, u << 16); }
__device__ __forceinline__ float silu_p(float x) { return x * __builtin_amdgcn_rcpf(1.0f + __expf(-x)); }
template <int CTRL> __device__ __forceinline__ float dpp_f(float x) { return __builtin_bit_cast(float, __builtin_amdgcn_update_dpp(0, __builtin_bit_cast(int, x), CTRL, 0xf, 0xf, true)); }
__device__ __forceinline__ float wave_sum(float v) {
    v += dpp_f<0xB1>(v); v += dpp_f<0x4E>(v); v += dpp_f<0x141>(v); v += dpp_f<0x140>(v);
    v += __shfl_xor(v, 16); v += __shfl_xor(v, 32);
    return v;
}
__device__ __forceinline__ float wave_max(float v) {
#pragma unroll
    for (int o = 1; o < 64; o <<= 1) v = fmaxf(v, __shfl_xor(v, o));
    return v;
}

struct Args { const float* in[28]; float* out; unsigned char* ws; int ph_lo, ph_hi; };
typedef const __attribute__((address_space(4))) Args* ArgsP;

#define XB_TMO      128
#define XB_XCNT(j)  (256  + 64 * (j))
#define XB_XSUB(j)  (1280 + 64 * (j))
#define XB_XGEN(j)  (2304 + 64 * (j))
#define XB_TOP      3328
#define XB_TOPGEN   3392
#define XCD_BAR_WORDS 3456
#define XB_SPIN_CAP (1u << 18)

__device__ __forceinline__ unsigned xb_ld(unsigned* p)              { return __hip_atomic_load(p, __ATOMIC_RELAXED, __HIP_MEMORY_SCOPE_AGENT); }
__device__ __forceinline__ unsigned xb_add(unsigned* p, unsigned v) { return __hip_atomic_fetch_add(p, v, __ATOMIC_RELAXED, __HIP_MEMORY_SCOPE_AGENT); }
__device__ __forceinline__ unsigned xb_xcc_id() { return (unsigned)__builtin_amdgcn_s_getreg((3 << 11) | 20) & 0xFu; }
#define XB_SPIN(cond, bar) do { unsigned _sp = 0; while (cond) { __builtin_amdgcn_s_sleep(1); \
    if ((++_sp & 255u) == 0u) { if (xb_ld(&(bar)[XB_TMO])) break; if (_sp > XB_SPIN_CAP) { atomicAdd(&(bar)[XB_TMO], 1u); break; } } } } while (0)

struct XcdBarrier {
    unsigned* bar; unsigned x;
    volatile LAS unsigned* st;
};

__device__ __forceinline__ XcdBarrier xcd_barrier_post(unsigned* bar, volatile LAS unsigned* st) {
    XcdBarrier b; b.bar = bar; b.x = xb_xcc_id(); b.st = st;
    if (threadIdx.x == 0) (void)xb_add(&bar[XB_XCNT(b.x)], 1u);
    return b;
}
__device__ __forceinline__ void xcd_barrier_complete(unsigned* bar, unsigned x, unsigned& nloc, unsigned& nx) {
    const unsigned G = gridDim.x * gridDim.y * gridDim.z;
    unsigned sum, cnt, mine, sp = 0u;
    for (;;) {
        sum = 0u; cnt = 0u; mine = 0u;
#pragma unroll
        for (unsigned j = 0; j < 16; ++j) { const unsigned c = xb_ld(&bar[XB_XCNT(j)]); sum += c; cnt += (c > 0u) ? 1u : 0u; mine = (j == x) ? c : mine; }
        if (sum == G) break;
        __builtin_amdgcn_s_sleep(1);
        if ((++sp & 255u) == 0u) { if (xb_ld(&bar[XB_TMO])) break; if (sp > XB_SPIN_CAP) { atomicAdd(&bar[XB_TMO], 1u); break; } }
    }
    nloc = mine > 0u ? mine : 1u; nx = cnt > 0u ? cnt : 1u;
}

__device__ __forceinline__ void xcd_barrier(const XcdBarrier& b) {
    asm volatile("s_waitcnt vmcnt(0)" ::: "memory");
    __syncthreads();
    if (threadIdx.x == 0) {
        unsigned* bar = b.bar;
        __builtin_amdgcn_s_waitcnt(0);
        unsigned nloc = b.st[0], nx = b.st[1];
        if (nloc == 0u) { xcd_barrier_complete(bar, b.x, nloc, nx); b.st[0] = nloc; b.st[1] = nx; }
        const unsigned old = xb_add(&bar[XB_XSUB(b.x)], 1u);
        const unsigned gen = old / nloc;
        if (old + 1u == (gen + 1u) * nloc) {
            __builtin_amdgcn_fence(__ATOMIC_RELEASE, "agent");
            asm volatile("s_waitcnt vmcnt(0)" ::: "memory");
            const unsigned og = xb_add(&bar[XB_TOP], 1u);
            const unsigned tg = og / nx;
            if (og + 1u == (tg + 1u) * nx) xb_add(&bar[XB_TOPGEN], 1u);
            else XB_SPIN(xb_ld(&bar[XB_TOPGEN]) == tg, bar);
            __builtin_amdgcn_fence(__ATOMIC_ACQUIRE, "agent");
            xb_add(&bar[XB_XGEN(b.x)], 1u);
            asm volatile("s_waitcnt vmcnt(0)" ::: "memory");
        } else {
            XB_SPIN(xb_ld(&bar[XB_XGEN(b.x)]) == gen, bar);
            __builtin_amdgcn_fence(__ATOMIC_ACQUIRE, "agent");
            asm volatile("s_waitcnt vmcnt(0)" ::: "memory");
        }
    }
    __syncthreads();
}

__device__ __forceinline__ void transpose_item(const float* W, int K, int N, bf16_t* WT, int rstride, int roff, LAS float* scr, int item, int lane) {
    const int nblk = N / 32, kb = item / nblk, nb = item % nblk, k0 = 64 * kb, n0 = 32 * nb;
    float tv[32];
#pragma unroll
    for (int i = 0; i < 32; ++i) { const int kk = 2 * i + (lane >> 5); tv[i] = W[(size_t)(k0 + kk) * N + n0 + (lane & 31)]; }
#pragma unroll
    for (int i = 0; i < 32; ++i) { const int kk = 2 * i + (lane >> 5); scr[kk * 33 + (lane & 31)] = tv[i]; }
    LDS_WAIT();
    const int c = lane & 7;
#pragma unroll
    for (int j = 0; j < 4; ++j) { const int n = (lane >> 3) + 8 * j; const LAS float* s = scr + (8 * c) * 33 + n;
        u32x4 o; o.x = pk2(s[0 * 33], s[1 * 33]); o.y = pk2(s[2 * 33], s[3 * 33]); o.z = pk2(s[4 * 33], s[5 * 33]); o.w = pk2(s[6 * 33], s[7 * 33]);
        const int nn = n0 + n, drow = (nn >> 7) * rstride + (nn & 127) + roff;
        *(u32x4*)(WT + (size_t)drow * K + k0 + 8 * c) = o; }
    LDS_WAIT();
}
constexpr int I_GU = 16 * 88, I_DN = 44 * 32, I_IN = 16 * 64, I_OUT = 16 * 32, I_MOD = 16 * 288, I_LW = 6 * I_GU + I_IN + I_OUT;
static_assert(I_GU == I_DN, "items");
constexpr int I_DEF = 2752;
__device__ __forceinline__ void transpose_layer_item(ArgsP a, int l, int r, LAS float* scr, int lane) {
    unsigned char* wl = a->ws + WS_WL + (size_t)l * WL_STRIDE;
    const float* src; bf16_t* dst; int K = D, N = FF, rs = 256, ro = 0;
    if (r < 0) { r += I_MOD; src = a->in[11] + (size_t)l * D * NMODL; dst = (bf16_t*)(a->ws + WS_WMOD) + (size_t)l * NMODL * D; N = NMODL; rs = 128; }
    else if (r < I_GU) { src = a->in[13] + (size_t)l * D * FF; dst = (bf16_t*)(wl + WL_GU1); }
    else if (r < 2 * I_GU) { r -= I_GU; src = a->in[14] + (size_t)l * D * FF; dst = (bf16_t*)(wl + WL_GU1); ro = 128; }
    else if (r < 3 * I_GU) { r -= 2 * I_GU; src = a->in[15] + (size_t)l * FF * D; dst = (bf16_t*)(wl + WL_D1); K = FF; N = D; rs = 128; }
    else if (r < 3 * I_GU + I_IN) { r -= 3 * I_GU; src = a->in[16] + (size_t)l * D * INW; dst = (bf16_t*)(wl + WL_WIN); N = INW; rs = 128; }
    else if (r < 3 * I_GU + I_IN + I_OUT) { r -= 3 * I_GU + I_IN; src = a->in[17] + (size_t)l * D * D; dst = (bf16_t*)(wl + WL_WOUT); N = D; rs = 128; }
    else if (r < 4 * I_GU + I_IN + I_OUT) { r -= 3 * I_GU + I_IN + I_OUT; src = a->in[24] + (size_t)l * D * FF; dst = (bf16_t*)(wl + WL_GU2); }
    else if (r < 5 * I_GU + I_IN + I_OUT) { r -= 4 * I_GU + I_IN + I_OUT; src = a->in[25] + (size_t)l * D * FF; dst = (bf16_t*)(wl + WL_GU2); ro = 128; }
    else { r -= 5 * I_GU + I_IN + I_OUT; src = a->in[26] + (size_t)l * FF * D; dst = (bf16_t*)(wl + WL_D2); K = FF; N = D; rs = 128; }
    transpose_item(src, K, N, dst, rs, ro, scr, r, lane);
}
__device__ __forceinline__ void deferred_transposes(ArgsP a, LAS unsigned char* lds, int l_next, int half, int first_idle, int tid, int G, int bx) {
    if (bx < first_idle) return;
    const int wave = tid >> 6, lane = tid & 63, wv = (bx - first_idle) * 8 + wave, NW = (G - first_idle) * 8;
    LAS float* scr = (LAS float*)(lds + wave * 16384);
    for (int it = half * (I_LW / 2) + wv; it < half * (I_LW / 2) + I_DEF; it += NW) transpose_layer_item(a, l_next, it, scr, lane);
}
__device__ __forceinline__ void phase_prologue(ArgsP a, LAS unsigned char* lds, int tid, int G, int bx) {
    const int wave = tid >> 6, lane = tid & 63, gw = bx * 8 + wave, NGW = G * 8;
    LAS float* scr = (LAS float*)(lds + wave * 16384);
    constexpr int I_REST = I_LW / 2 - I_DEF, N_A = DEPTH * I_MOD, N_B = N_A + I_LW, N_C = N_B + 3 * 2 * I_REST;
    for (int it = gw; it < N_C; it += NGW) { int l, r;
        if (it < N_A) { l = it / I_MOD; r = it % I_MOD - I_MOD; }
        else if (it < N_B) { l = 0; r = it - N_A; }
        else { const int q = it - N_B, lh = q / I_REST; l = 1 + (lh >> 1); r = (lh & 1) * (I_LW / 2) + I_DEF + q % I_REST; }
        transpose_layer_item(a, l, r, scr, lane); }
    const int gt = bx * 512 + tid, NT = G * 512;
    bf16_t* SC = (bf16_t*)(a->ws + WS_SC);
    for (int i = gt; i < 256 * D; i += NT) { const int r = i >> 10, d = i & 1023; float v = 0.f;
        if (r < 8) v = silu_p(a->in[2][r * D + d]); else if (r < 136) v = silu_p(a->in[3][(r - 8) * D + d]);
        SC[i] = (bf16_t)f2bf(v); }
    if (bx == 0) { unsigned* bw = (unsigned*)a->ws; for (int i = tid; i < XCD_BAR_WORDS; i += 512) bw[i] = 0u; }
    if (bx == 0 && tid < 256) { float* LBS = (float*)(a->ws + WS_LBS); const float* hl = a->in[20];
        const float a0 = hl[tid], a1 = hl[256 + tid], a2 = hl[512 + tid], a3 = hl[768 + tid]; const float mx = fmaxf(fmaxf(a0, a1), fmaxf(a2, a3));
        const float e0 = expf(a0 - mx), e1 = expf(a1 - mx), e2 = expf(a2 - mx), e3 = expf(a3 - mx), s = e0 + e1 + e2 + e3;
        LBS[tid] = 0.f; LBS[256 + tid] = e1 / s; LBS[512 + tid] = (e1 + e2) / s; LBS[768 + tid] = (e1 + e2 + e3) / s; }
}

template <bool FINAL>
__device__ __forceinline__ void phase_norm(ArgsP a, const float* nw, int modcol, bool first, int tid, int G, int bx) {
    const int wave = tid >> 6, lane = tid & 63, gw = bx * 8 + wave, NGW = G * 8;
    float* X = a->out; bf16_t* H = (bf16_t*)(a->ws + WS_H); const float* MOD = (const float*)(a->ws + WS_MOD);
    f32x4 nv[4];
#pragma unroll
    for (int j = 0; j < 4; ++j) nv[j] = ((const f32x4*)nw)[lane + 64 * j];
    for (int row = 2 * gw; row < MT; row += 2 * NGW) {
        f32x4* xr = (f32x4*)(X + (size_t)row * D) + lane; f32x4 v[2][4]; float s0 = 0.f, s1 = 0.f;
        const f32x4* xs = first ? (const f32x4*)(row < MP ? a->in[0] + (size_t)row * D : a->in[1] + (size_t)(row - MP) * D) + lane : xr;
#pragma unroll
        for (int j = 0; j < 4; ++j) { v[0][j] = xs[64 * j]; v[1][j] = xs[256 + 64 * j]; }
        f32x4 sh[4], sc[4];
        if (!FINAL) { const float* mp = MOD + (size_t)pg8::row_batch(row) * NMOD + modcol;
#pragma unroll
            for (int j = 0; j < 4; ++j) { sh[j] = ((const f32x4*)mp)[lane + 64 * j]; sc[j] = ((const f32x4*)(mp + D))[lane + 64 * j]; } }
#pragma unroll
        for (int j = 0; j < 4; ++j) { s0 += (v[0][j].x * v[0][j].x + v[0][j].y * v[0][j].y) + (v[0][j].z * v[0][j].z + v[0][j].w * v[0][j].w);
            s1 += (v[1][j].x * v[1][j].x + v[1][j].y * v[1][j].y) + (v[1][j].z * v[1][j].z + v[1][j].w * v[1][j].w); }
        s0 = wave_sum(s0); s1 = wave_sum(s1);
        const float r0 = __builtin_amdgcn_rsqf(s0 * (1.0f / D) + EPS), r1 = __builtin_amdgcn_rsqf(s1 * (1.0f / D) + EPS);
        if (FINAL) {
#pragma unroll
            for (int j = 0; j < 4; ++j) { xr[64 * j] = (v[0][j] * r0) * nv[j]; xr[256 + 64 * j] = (v[1][j] * r1) * nv[j]; }
        } else {
            unsigned long long* o8 = (unsigned long long*)(H + (size_t)row * D) + lane;
#pragma unroll
            for (int j = 0; j < 4; ++j) { const f32x4 c = nv[j] * (sc[j] + 1.0f);
                const f32x4 h0 = ((v[0][j] * r0) * nv[j]) * (sc[j] + 1.0f) + sh[j], h1 = ((v[1][j] * r1) * nv[j]) * (sc[j] + 1.0f) + sh[j]; (void)c;
                o8[64 * j] = (unsigned long long)pk2(h0.x, h0.y) | ((unsigned long long)pk2(h0.z, h0.w) << 32);
                o8[256 + 64 * j] = (unsigned long long)pk2(h1.x, h1.y) | ((unsigned long long)pk2(h1.z, h1.w) << 32); }
        }
    }
}

__device__ __forceinline__ void attn_prompt_item(LAS unsigned char* lds, const bf16_t* Z, bf16_t* Y, const float* sinks, const float* relb, int item, int tid) {
    const int b = item >> 6, qblk = (item >> 1) & 31, kvh = item & 1, q0 = qblk * 64, rowbase = b * TP;
    LAS unsigned char* Ks = lds;
    LAS bf16_t* Vt = (LAS bf16_t*)(lds + 27648);
    LAS float* tab = (LAS float*)(lds + 27648 + 25088);
    const int w = tid >> 6, lane = tid & 63, hl = w >> 1, qsub = w & 1, head = kvh * 4 + hl, r = lane & 31, hi = lane >> 5;
    const int qi = qsub * 32 + r; const size_t qrow = (size_t)rowbase + q0 + qi;
    bf16x8 qf[4];
#pragma unroll
    for (int s = 0; s < 4; ++s) qf[s] = *(const bf16x8*)(Z + qrow * INW + OFF_AQ + head * 64 + 16 * s + 8 * hi);
    u32x4 kv[3], vv[3];
#pragma unroll
    for (int i = 0; i < 3; ++i) { const int ch = tid + i * 512, key = ch >> 3, c8 = ch & 7, kp = max(q0 - 128 + key, 0);
        const bf16_t* zr = Z + (size_t)(rowbase + kp) * INW + kvh * 64 + c8 * 8; kv[i] = *(const u32x4*)(zr + OFF_AK); vv[i] = *(const u32x4*)(zr + OFF_AV); }
#pragma unroll
    for (int i = 0; i < 3; ++i) {
        const int ch = tid + i * 512, key = ch >> 3, c8 = ch & 7;
        if (q0 - 128 + key < 0) { kv[i] = (u32x4){0u, 0u, 0u, 0u}; vv[i] = (u32x4){0u, 0u, 0u, 0u}; }
        *(LAS u32x4*)(Ks + key * 144 + c8 * 16) = kv[i];
#pragma unroll
        for (int e = 0; e < 8; ++e) Vt[(c8 * 8 + e) * 196 + key] = (bf16_t)((vv[i][e >> 1] >> (16 * (e & 1))) & 0xffffu);
    }
    { const int hl = tid >> 7, n = tid & 127; tab[tid] = relb[(int)c_bucket[n] * 8 + kvh * 4 + hl]; }
    __syncthreads();
    const float sink = sinks[head]; const unsigned nlim = (unsigned)min(127, q0 + qi);
    float mx = -INFINITY;
#pragma unroll 1
    for (int tt = 0; tt < 5; ++tt) { f32x16 acc;
#pragma unroll
        for (int i = 0; i < 16; ++i) acc[i] = 0.f;
        const LAS unsigned char* kb = Ks + ((qsub + tt) * 32 + r) * 144 + 16 * hi;
#pragma unroll
        for (int s = 0; s < 4; ++s) { const bf16x8 kf = *(const LAS bf16x8*)(kb + 32 * s); acc = __builtin_amdgcn_mfma_f32_32x32x16_bf16(kf, qf[s], acc, 0, 0, 0); }
        const int nb = r + 128 - tt * 32 - 4 * hi; const LAS float* tb = tab + hl * 128;
#pragma unroll
        for (int i = 0; i < 16; ++i) { const int n = nb - ((i & 3) + 8 * (i >> 2));
            const float lg = acc[i] * 0.125f + tb[n & 127]; mx = fmaxf(mx, ((unsigned)n <= nlim) ? lg : -INFINITY); } }
    mx = fmaxf(mx, __shfl_xor(mx, 32)); mx = fmaxf(mx, sink);
    float sum = 0.f;
    f32x16 oacc[2];
#pragma unroll
    for (int dt = 0; dt < 2; ++dt)
#pragma unroll
        for (int i = 0; i < 16; ++i) oacc[dt][i] = 0.f;
#pragma unroll 1
    for (int tt = 0; tt < 5; ++tt) { f32x16 acc;
#pragma unroll
        for (int i = 0; i < 16; ++i) acc[i] = 0.f;
        const LAS unsigned char* kb = Ks + ((qsub + tt) * 32 + r) * 144 + 16 * hi;
#pragma unroll
        for (int s = 0; s < 4; ++s) { const bf16x8 kf = *(const LAS bf16x8*)(kb + 32 * s); acc = __builtin_amdgcn_mfma_f32_32x32x16_bf16(kf, qf[s], acc, 0, 0, 0); }
        const int nb = r + 128 - tt * 32 - 4 * hi; const LAS float* tb = tab + hl * 128;
#pragma unroll
        for (int i = 0; i < 16; ++i) { const int n = nb - ((i & 3) + 8 * (i >> 2));
            const float lg = acc[i] * 0.125f + tb[n & 127]; const float p = ((unsigned)n <= nlim) ? __expf(lg - mx) : 0.f; acc[i] = p; sum += p; }
#pragma unroll
        for (int s = 0; s < 2; ++s) {
            u32x4 pw; pw.x = pk2(acc[8 * s + 0], acc[8 * s + 1]); pw.y = pk2(acc[8 * s + 2], acc[8 * s + 3]); pw.z = pk2(acc[8 * s + 4], acc[8 * s + 5]); pw.w = pk2(acc[8 * s + 6], acc[8 * s + 7]);
            const bf16x8 pf = __builtin_bit_cast(bf16x8, pw);
#pragma unroll
            for (int dt = 0; dt < 2; ++dt) { const LAS bf16_t* vp = Vt + (dt * 32 + r) * 196 + (qsub + tt) * 32 + 16 * s + 4 * hi;
                const u32x2 lo = *(const LAS u32x2*)vp, hh = *(const LAS u32x2*)(vp + 8); u32x4 vw; vw.x = lo.x; vw.y = lo.y; vw.z = hh.x; vw.w = hh.y;
                oacc[dt] = __builtin_amdgcn_mfma_f32_32x32x16_bf16(__builtin_bit_cast(bf16x8, vw), pf, oacc[dt], 0, 0, 0); }
        } }
    sum += __shfl_xor(sum, 32);
    const float inv = __builtin_amdgcn_rcpf(sum + __expf(sink - mx));
    bf16_t* yr = Y + qrow * D + 512 + head * 64;
#pragma unroll
    for (int dt = 0; dt < 2; ++dt)
#pragma unroll
        for (int g4 = 0; g4 < 4; ++g4) { u32x2 o; o.x = pk2(oacc[dt][4 * g4 + 0] * inv, oacc[dt][4 * g4 + 1] * inv); o.y = pk2(oacc[dt][4 * g4 + 2] * inv, oacc[dt][4 * g4 + 3] * inv);
            *(u32x2*)(yr + dt * 32 + 8 * g4 + 4 * hi) = o; }
    __syncthreads();
}
__device__ __forceinline__ void attn_sample_item(LAS unsigned char* lds, ArgsP a, int l, const bf16_t* Z, bf16_t* Y, const float* sinks, const float* relb, int item, int tid) {
    const int b = item >> 1, kvh = item & 1;
    LAS float* Kx = (LAS float*)lds;
    LAS float* Vx = (LAS float*)(lds + 35904);
    LAS float* Qs = (LAS float*)(lds + 69696);
    LAS float* Ps = (LAS float*)(lds + 73792);
    LAS float* tab = (LAS float*)(lds + 82496);
    const size_t cbase = (size_t)(l * 128 + b) * 128 * 128;
    const float* ck = a->in[6] + cbase; const float* cv = a->in[7] + cbase; float* nk = a->out + O_KS + cbase; float* nv = a->out + O_VS + cbase;
    { float kx[16], vx[16]; const int d = tid & 63, j0 = tid >> 6;
#pragma unroll
      for (int i = 0; i < 16; ++i) { kx[i] = ck[(j0 + 8 * i) * 128 + kvh * 64 + d]; vx[i] = cv[(j0 + 8 * i) * 128 + kvh * 64 + d]; }
      unsigned zk = 0, zv = 0, zq0, zq1;
      { const int t = (tid >> 6) & 3; const bf16_t* zr = Z + (size_t)(MP + b * 4 + t) * INW + kvh * 64 + d; zk = zr[OFF_AK]; zv = zr[OFF_AV]; }
      { const int rr = tid >> 6, hl = rr >> 2, t = rr & 3; zq0 = Z[(size_t)(MP + b * 4 + t) * INW + OFF_AQ + (kvh * 4 + hl) * 64 + d]; zq1 = Z[(size_t)(MP + b * 4 + t) * INW + OFF_AQ + (kvh * 4 + hl + 2) * 64 + d]; }
#pragma unroll
      for (int i = 0; i < 16; ++i) { const int j = j0 + 8 * i; Kx[j * 68 + d] = kx[i]; Vx[j * 64 + d] = vx[i];
          if (j >= 4) { nk[(j - 4) * 128 + kvh * 64 + d] = kx[i]; nv[(j - 4) * 128 + kvh * 64 + d] = vx[i]; } }
      if (tid < 256) { const int t = tid >> 6; const float k1 = bf2f(zk), v1 = bf2f(zv);
          Kx[(128 + t) * 68 + d] = k1; Vx[(128 + t) * 64 + d] = v1; nk[(124 + t) * 128 + kvh * 64 + d] = k1; nv[(124 + t) * 128 + kvh * 64 + d] = v1; }
      Qs[tid] = bf2f(zq0); Qs[tid + 512] = bf2f(zq1); }
    { const int hl = tid >> 7, n = tid & 127; tab[tid] = relb[(int)c_bucket[n] * 8 + kvh * 4 + hl]; }
    __syncthreads();
    const int w = tid >> 6, lane = tid & 63;
#pragma unroll
    for (int r2 = 0; r2 < 2; ++r2) { const int row = 2 * w + r2, hl = row >> 2, t = row & 3; const float sink = sinks[kvh * 4 + hl];
        float lg[3]; float mx = -INFINITY;
#pragma unroll
        for (int ps = 0; ps < 3; ++ps) { const int key = lane + 64 * ps; float v = -INFINITY;
            if (key < 132) { float dot = 0.f; const LAS f32x4* q4 = (const LAS f32x4*)(Qs + row * 64); const LAS f32x4* k4 = (const LAS f32x4*)(Kx + key * 68);
#pragma unroll
                for (int d = 0; d < 16; ++d) { const f32x4 qa = q4[d], ka = k4[d]; dot += (qa.x * ka.x + qa.y * ka.y) + (qa.z * ka.z + qa.w * ka.w); }
                const int n = t + 128 - key; if (n >= 0 && n < 128) v = dot * 0.125f + tab[hl * 128 + n]; }
            lg[ps] = v; mx = fmaxf(mx, v); }
        mx = fmaxf(wave_max(mx), sink);
        float p[3], sum = 0.f;
#pragma unroll
        for (int ps = 0; ps < 3; ++ps) { p[ps] = __expf(lg[ps] - mx); sum += p[ps]; }
        const float inv = __builtin_amdgcn_rcpf(wave_sum(sum) + __expf(sink - mx));
#pragma unroll
        for (int ps = 0; ps < 3; ++ps) { const int key = lane + 64 * ps; if (key < 132) Ps[row * 136 + key] = p[ps] * inv; }
        LDS_WAIT();
        float o = 0.f;
#pragma unroll 4
        for (int key = 0; key < 132; ++key) o += Ps[row * 136 + key] * Vx[key * 64 + lane];
        Y[(size_t)(MP + b * 4 + t) * D + 512 + (kvh * 4 + hl) * 64 + lane] = (bf16_t)f2bf(o);
    }
    __syncthreads();
}

__device__ __forceinline__ void pool_item(LAS unsigned char* lds, const bf16_t* Z, bf16_t* Y, const float* pw, const float* psc, bool sample, int rowbase, int t0, const float* prefix, float* newpool, int tid) {
    const int ntok = sample ? 4 : 32, nrows = ntok + 15, tph = ntok >> 1;
    LAS float* ext = (LAS float*)lds;
    LAS float* dbuf = (LAS float*)(lds + 48128);
    if (sample) {
        f32x4 p0[2], p1[2]; u32x4 zz = {0u, 0u, 0u, 0u};
#pragma unroll
        for (int k = 0; k < 2; ++k) { const int c = min(tid + k * 512, 479), i = c >> 5, c8 = c & 31; p0[k] = *(const f32x4*)(prefix + i * 256 + c8 * 8); p1[k] = *(const f32x4*)(prefix + i * 256 + c8 * 8 + 4); }
        if (tid < 128) zz = *(const u32x4*)(Z + (size_t)(rowbase + (tid >> 5)) * INW + (tid & 31) * 8);
#pragma unroll
        for (int k = 0; k < 2; ++k) { const int c = tid + k * 512; if (c < 480) { const int i = c >> 5, c8 = c & 31; *(LAS f32x4*)(ext + i * 256 + c8 * 8) = p0[k]; *(LAS f32x4*)(ext + i * 256 + c8 * 8 + 4) = p1[k]; } }
        if (tid < 128) { const int i = 15 + (tid >> 5), c8 = tid & 31; f32x4 v0, v1;
            v0.x = bf2f(zz.x & 0xffffu); v0.y = bf2f(zz.x >> 16); v0.z = bf2f(zz.y & 0xffffu); v0.w = bf2f(zz.y >> 16); v1.x = bf2f(zz.z & 0xffffu); v1.y = bf2f(zz.z >> 16); v1.z = bf2f(zz.w & 0xffffu); v1.w = bf2f(zz.w >> 16);
            *(LAS f32x4*)(ext + i * 256 + c8 * 8) = v0; *(LAS f32x4*)(ext + i * 256 + c8 * 8 + 4) = v1; }
    } else {
        u32x4 zz[3];
#pragma unroll
        for (int k = 0; k < 3; ++k) { const int c = min(tid + k * 512, 1503), i = c >> 5, c8 = c & 31, tl = max(i - 15, -t0); zz[k] = *(const u32x4*)(Z + (size_t)(rowbase + tl) * INW + c8 * 8); }
#pragma unroll
        for (int k = 0; k < 3; ++k) { const int c = tid + k * 512; if (c < 1504) { const int i = c >> 5, c8 = c & 31; u32x4 z = zz[k]; if (t0 + i - 15 < 0) z = (u32x4){0u, 0u, 0u, 0u}; f32x4 v0, v1;
            v0.x = bf2f(z.x & 0xffffu); v0.y = bf2f(z.x >> 16); v0.z = bf2f(z.y & 0xffffu); v0.w = bf2f(z.y >> 16); v1.x = bf2f(z.z & 0xffffu); v1.y = bf2f(z.z >> 16); v1.z = bf2f(z.w & 0xffffu); v1.w = bf2f(z.w >> 16);
            *(LAS f32x4*)(ext + i * 256 + c8 * 8) = v0; *(LAS f32x4*)(ext + i * 256 + c8 * 8 + 4) = v1; } }
    }
    __syncthreads();
    const int ch = tid & 255, half = tid >> 8, g = ch >> 6, wlen = 2 << g, gd = ch & 63;
    { const int tb0 = half * tph; const LAS float* ep = ext + (15 + tb0) * 256 + ch; float s = 0.f;
#pragma unroll
      for (int q = 0; q < 16; ++q) { const float v = ep[-q * 256]; s += (q < wlen) ? v : 0.f; }
#pragma unroll
      for (int tt = 0; tt < 16; ++tt) if (tt < tph) { const float cur = ep[tt * 256];
          if (tt > 0) s += cur - ep[(tt - wlen) * 256];
          const int cnt = sample ? wlen : min(t0 + tb0 + tt + 1, wlen);
          dbuf[(tb0 + tt) * 256 + ch] = s * __builtin_amdgcn_rcpf((float)cnt) - cur; } }
    if (newpool) for (int idx = tid; idx < 15 * 256; idx += 512) newpool[idx] = ext[(nrows - 15) * 256 + idx];
    __syncthreads();
    float acc[16];
#pragma unroll
    for (int tt = 0; tt < 16; ++tt) acc[tt] = 0.f;
    const float* wp = pw + (size_t)(g * 64) * 64 + gd;
    float wa0 = wp[0], wa1 = wp[64], wa2 = wp[128], wa3 = wp[192], wb0 = wp[256], wb1 = wp[320], wb2 = wp[384], wb3 = wp[448];
#pragma unroll 1
    for (int c4 = 0; c4 < 16; ++c4) {
        const float* wn = wp + (size_t)min(c4 + 2, 15) * 256; const float wc0 = wn[0], wc1 = wn[64], wc2 = wn[128], wc3 = wn[192];
        const LAS float* dp = dbuf + (half * tph) * 256 + g * 64 + c4 * 4;
#pragma unroll
        for (int tt = 0; tt < 16; ++tt) if (tt < tph) { const f32x4 d4 = *(const LAS f32x4*)(dp + tt * 256);
            acc[tt] += (d4.x * wa0 + d4.y * wa1) + (d4.z * wa2 + d4.w * wa3); }
        wa0 = wb0; wa1 = wb1; wa2 = wb2; wa3 = wb3; wb0 = wc0; wb1 = wc1; wb2 = wc2; wb3 = wc3;
    }
    const float sc = psc[ch];
#pragma unroll
    for (int tt = 0; tt < 16; ++tt) if (tt < tph) Y[(size_t)(rowbase + half * tph + tt) * D + ch] = (bf16_t)f2bf(acc[tt] * sc);
    __syncthreads();
}

template <bool OUT, int NSTEPS>
__device__ __forceinline__ void hgrn_run(LAS float* wl, const bf16_t* Z, bf16_t* Y, int row0, int h, float lbv, float hgn, f32x2 (&S)[32], float& P, int lane) {
    LAS float* fb = wl; LAS float* qb = wl + 1024; LAS unsigned* vg = (LAS unsigned*)(wl + 2048); LAS float* obuf = wl + 3072;
    const LAS f32x4* fb4 = (const LAS f32x4*)fb; const LAS f32x4* qb4 = (const LAS f32x4*)qb;
    constexpr int nst = NSTEPS < 16 ? NSTEPS : 16; static_assert(NSTEPS <= 16 || NSTEPS % 16 == 0, "steps");
    for (int t0 = 0; t0 < NSTEPS; t0 += 16) {
        unsigned rf[nst], ri[nst], rq[nst], rg[nst];
#pragma unroll
        for (int tt = 0; tt < nst; ++tt) { const bf16_t* zr = Z + (size_t)(row0 + t0 + tt) * INW + h * 64 + lane;
            rf[tt] = zr[OFF_HF]; ri[tt] = zr[OFF_HI]; if (OUT) { rq[tt] = zr[OFF_HQ]; rg[tt] = zr[OFF_HG]; } }
#pragma unroll
        for (int tt = 0; tt < nst; ++tt) {
            const float f = lbv + (1.0f - lbv) * __builtin_amdgcn_rcpf(1.0f + __expf(-bf2f(rf[tt]))); fb[tt * 64 + lane] = f; P *= f;
            unsigned pv = ri[tt];
            if (OUT) { qb[tt * 64 + lane] = silu_p(bf2f(rq[tt])); pv |= rg[tt] << 16; }
            vg[tt * 64 + lane] = pv; }
        LDS_WAIT();
        f32x4 fA[4], qA[4], fB[4], qB[4];
#pragma unroll
        for (int i = 0; i < 4; ++i) { fA[i] = fb4[i]; if (OUT) qA[i] = qb4[i]; }
#define HG_PART(FX, QX, base) _Pragma("unroll") for (int i = 0; i < 4; ++i) { const f32x2 f0 = __builtin_shufflevector(FX[i], FX[i], 0, 1), f1 = __builtin_shufflevector(FX[i], FX[i], 2, 3); \
                S[(base) + 2 * i] = f0 * (S[(base) + 2 * i] - v2) + v2; S[(base) + 2 * i + 1] = f1 * (S[(base) + 2 * i + 1] - v2) + v2; \
                if (OUT) { oa += S[(base) + 2 * i] * __builtin_shufflevector(QX[i], QX[i], 0, 1); ob += S[(base) + 2 * i + 1] * __builtin_shufflevector(QX[i], QX[i], 2, 3); } }
#define HG_LOAD(FX, QX, idx) _Pragma("unroll") for (int i = 0; i < 4; ++i) { FX[i] = fb4[(idx) + i]; if (OUT) QX[i] = qb4[(idx) + i]; }
#pragma unroll 1
        for (int tt = 0; tt < nst; ++tt) {
            const unsigned pv = vg[tt * 64 + lane]; const float v = bf2f(pv & 0xffffu); const f32x2 v2 = {v, v};
            f32x2 oa = {0.f, 0.f}, ob = {0.f, 0.f};
            const int tn = min(tt + 1, 15);
            HG_LOAD(fB, qB, tt * 16 + 4);  HG_PART(fA, qA, 0);
            HG_LOAD(fA, qA, tt * 16 + 8);  HG_PART(fB, qB, 8);
            HG_LOAD(fB, qB, tt * 16 + 12); HG_PART(fA, qA, 16);
            HG_LOAD(fA, qA, tn * 16);      HG_PART(fB, qB, 24);
            if (OUT) obuf[tt * 64 + lane] = (oa.x + oa.y) + (ob.x + ob.y);
        }
        if (OUT) {
#pragma unroll
            for (int tt = 0; tt < 16; ++tt) if (tt < nst) { const float o = obuf[tt * 64 + lane]; const float ms = wave_sum(o * o) * (1.0f / 64.0f); const float on = o * __builtin_amdgcn_rsqf(ms + EPS) * hgn;
                Y[(size_t)(row0 + t0 + tt) * D + 256 + h * 64 + lane] = (bf16_t)f2bf(on * silu_p(bf2f(vg[tt * 64 + lane] >> 16))); }
        }
#undef HG_PART
#undef HG_LOAD
        LDS_WAIT();
    }
}

__device__ __forceinline__ void phase_mix1(ArgsP a, LAS unsigned char* lds, int l, int tid, int G, int bx) {
    const bf16_t* Z = (const bf16_t*)(a->ws + WS_Z); bf16_t* Y = (bf16_t*)(a->ws + WS_Y);
    const float* sinks = a->in[22] + l * 8; const float* relb = a->in[23];
for (int rp_ = 0; rp_ < (MIXPROBE == 1 ? 2 : 1); ++rp_) {
        for (int it = bx; it < 512; it += G) attn_prompt_item(lds, Z, Y, sinks, relb, it, tid);
    }
for (int rp_ = 0; rp_ < (MIXPROBE == 2 ? 2 : 1); ++rp_) {
        for (int it = bx; it < 256; it += G) attn_sample_item(lds, a, l, Z, Y, sinks, relb, it, tid);
    }
    const float* pw = a->in[18] + (size_t)l * 4 * 64 * 64; const float* psc = a->in[19] + l * 256;
for (int rp_ = 0; rp_ < (MIXPROBE == 3 ? 2 : 1); ++rp_) {
        for (int it = bx; it < 512; it += G) { const int b = it >> 6, tb = it & 63;
        pool_item(lds, Z, Y, pw, psc, false, b * TP + tb * 32, tb * 32, nullptr, tb == 63 ? a->out + O_POOLP + (size_t)(l * 8 + b) * 15 * 256 : nullptr, tid); }
    for (int it = bx; it < 128; it += G)
        pool_item(lds, Z, Y, pw, psc, true, MP + it * 4, 0, a->in[4] + (size_t)(l * 128 + it) * 15 * 256, a->out + O_POOLS + (size_t)(l * 128 + it) * 15 * 256, tid);
    }
    { const int gt = bx * 512 + tid, NT = G * 512; float* okp = a->out + O_KP + (size_t)l * 8 * 128 * 128; float* ovp = a->out + O_VP + (size_t)l * 8 * 128 * 128;
      for (int i = gt; i < 8 * 128 * 128; i += NT) { const int c = i & 127, j = (i >> 7) & 127, b = i >> 14; const bf16_t* zr = Z + (size_t)(b * TP + 1920 + j) * INW + c;
          okp[i] = bf2f(zr[OFF_AK]); ovp[i] = bf2f(zr[OFF_AV]); } }
    const int wave = tid >> 6, lane = tid & 63, gw = bx * 8 + wave, NGW = G * 8;
    LAS float* wl = (LAS float*)(lds + wave * 16384);
    const float* LBS = (const float*)(a->ws + WS_LBS) + l * 256; float* HU = (float*)(a->ws + WS_HU); float* HP = (float*)(a->ws + WS_HP);
for (int rp_ = 0; rp_ < (MIXPROBE == 4 ? 2 : 1); ++rp_) {
        for (int it = gw; it < 32 * HNC; it += NGW) { const int sq = it / HNC, c = it % HNC, b = sq >> 2, h = sq & 3;
        f32x2 S[32]; float P = 1.0f;
#pragma unroll
        for (int k = 0; k < 32; ++k) S[k] = (f32x2){0.f, 0.f};
        hgrn_run<false, HL>(wl, Z, Y, b * TP + c * HL, h, LBS[h * 64 + lane], 0.f, S, P, lane);
        float* up = HU + (size_t)it * 4096 + lane;
#pragma unroll
        for (int k = 0; k < 64; ++k) up[k * 64] = S[k >> 1][k & 1];
        HP[(size_t)it * 64 + lane] = P; }
    }
    const float hgn = a->in[21][l * 64 + lane];
for (int rp_ = 0; rp_ < (MIXPROBE == 5 ? 2 : 1); ++rp_) {
        for (int it = gw; it < 512; it += NGW) { const int b = it >> 2, h = it & 3;
        const float* s0 = a->in[5] + (size_t)((l * 128 + b) * 4 + h) * 4096 + lane; f32x2 S[32]; float P = 1.0f;
#pragma unroll
        for (int k = 0; k < 64; ++k) S[k >> 1][k & 1] = s0[k * 64];
        hgrn_run<true, 4>(wl, Z, Y, MP + b * 4, h, LBS[h * 64 + lane], hgn, S, P, lane);
        float* so = a->out + O_HGS + (size_t)((l * 128 + b) * 4 + h) * 4096 + lane;
#pragma unroll
        for (int k = 0; k < 64; ++k) so[k * 64] = S[k >> 1][k & 1]; }
    }
}
__device__ __forceinline__ void phase_mix2(ArgsP a, int tid, int G, int bx) {
    float* HU = (float*)(a->ws + WS_HU); const float* HP = (const float*)(a->ws + WS_HP);
    for (int e = bx * 512 + tid; e < 32 * 4096; e += G * 512) { const int sq = e >> 12, idx = e & 4095, k = idx >> 6;
        float* up = HU + (size_t)sq * HNC * 4096 + idx; const float* pp = HP + (size_t)sq * HNC * 64 + k; float S = 0.f;
        for (int c0 = 0; c0 < HNC; c0 += 32) { float u[32], p[32];
#pragma unroll
            for (int i = 0; i < 32; ++i) { u[i] = up[(size_t)(c0 + i) * 4096]; p[i] = pp[(c0 + i) * 64]; }
#pragma unroll
            for (int i = 0; i < 32; ++i) { up[(size_t)(c0 + i) * 4096] = S; S = __builtin_fmaf(p[i], S, u[i]); } } }
}
__device__ __forceinline__ void phase_mix3(ArgsP a, LAS unsigned char* lds, int l, int tid, int G, int bx) {
    const bf16_t* Z = (const bf16_t*)(a->ws + WS_Z); bf16_t* Y = (bf16_t*)(a->ws + WS_Y);
    const int wave = tid >> 6, lane = tid & 63, gw = bx * 8 + wave, NGW = G * 8;
    LAS float* wl = (LAS float*)(lds + wave * 16384);
    const float* LBS = (const float*)(a->ws + WS_LBS) + l * 256; const float* HU = (const float*)(a->ws + WS_HU);
    const float hgn = a->in[21][l * 64 + lane];
    for (int it = gw; it < 32 * HNC; it += NGW) { const int sq = it / HNC, c = it % HNC, b = sq >> 2, h = sq & 3;
        const float* up = HU + (size_t)it * 4096 + lane; f32x2 S[32]; float P = 1.0f;
#pragma unroll
        for (int k = 0; k < 64; ++k) S[k >> 1][k & 1] = up[k * 64];
        hgrn_run<true, HL>(wl, Z, Y, b * TP + c * HL, h, LBS[h * 64 + lane], hgn, S, P, lane);
        if (c == HNC - 1) { float* so = a->out + O_HGP + (size_t)((l * 8 + b) * 4 + h) * 4096 + lane;
#pragma unroll
            for (int k = 0; k < 64; ++k) so[k * 64] = S[k >> 1][k & 1]; } }
}

struct SkResid { float* X; const float* Xin; const float* gate; int gpitch; float coef;
    __device__ __forceinline__ void operator()(int row, int col, f32x4 v) const { float* xp = X + (size_t)row * D + col; const float* gp = gate + (size_t)pg8::row_batch(row) * gpitch + col;
        f32x4 x = *(const f32x4*)(Xin + (size_t)row * D + col); x = x + (*(const f32x4*)gp * coef) * v; *(f32x4*)xp = x; } };
struct SkBf16 { bf16_t* O; int ldc;
    __device__ __forceinline__ void operator()(int row, int col, f32x4 v) const { u32x2 w; w.x = pk2(v.x, v.y); w.y = pk2(v.z, v.w); *(u32x2*)(O + (size_t)row * ldc + col) = w; } };
template <class F>
__device__ __forceinline__ void skinny_gemm(LAS unsigned char* lds, const bf16_t* A, const bf16_t* Bt, int N, int K, int row_off, int tid, int bx, int G, const F& epi) {
    const int w = tid >> 6, lane = tid & 63, fr = lane & 15, fq = lane >> 4;
    const int ntn = N >> 6, ntiles = 16 * ntn, ksl = K >> 3, nks = ksl >> 5;
    LAS float* red = (LAS float*)lds;
    for (int tile = bx; tile < ntiles; tile += G) {
        const int tm = tile / ntn, tn = tile % ntn;
        f32x4 acc[2][4];
#pragma unroll
        for (int mi = 0; mi < 2; ++mi)
#pragma unroll
            for (int ni = 0; ni < 4; ++ni) acc[mi][ni] = (f32x4){0.f, 0.f, 0.f, 0.f};
        const bf16_t* ap = A + (size_t)(tm * 32 + fr) * K + w * ksl + fq * 8;
        const bf16_t* bp = Bt + (size_t)(tn * 64 + fr) * K + w * ksl + fq * 8;
        for (int s0 = 0; s0 < nks; s0 += 4) {
            bf16x8 af[4][2], bfr[4][4];
#pragma unroll
            for (int s = 0; s < 4; ++s) { const int ss = min(s0 + s, nks - 1);
#pragma unroll
                for (int mi = 0; mi < 2; ++mi) af[s][mi] = *(const bf16x8*)(ap + (size_t)mi * 16 * K + ss * 32);
#pragma unroll
                for (int ni = 0; ni < 4; ++ni) bfr[s][ni] = *(const bf16x8*)(bp + (size_t)ni * 16 * K + ss * 32); }
#pragma unroll
            for (int s = 0; s < 4; ++s) if (s0 + s < nks) {
#pragma unroll
                for (int mi = 0; mi < 2; ++mi)
#pragma unroll
                    for (int ni = 0; ni < 4; ++ni) acc[mi][ni] = __builtin_amdgcn_mfma_f32_16x16x32_bf16(af[s][mi], bfr[s][ni], acc[mi][ni], 0, 0, 0); }
        }
#pragma unroll
        for (int mi = 0; mi < 2; ++mi)
#pragma unroll
            for (int ni = 0; ni < 4; ++ni)
#pragma unroll
                for (int r = 0; r < 4; ++r) red[(w * 32 + mi * 16 + fq * 4 + r) * 64 + ni * 16 + fr] = acc[mi][ni][r];
        __syncthreads();
        { const int row = tid >> 4, c4 = (tid & 15) * 4; f32x4 sum = {0.f, 0.f, 0.f, 0.f};
#pragma unroll
          for (int ww = 0; ww < 8; ++ww) sum = sum + *(const LAS f32x4*)(red + (ww * 32 + row) * 64 + c4);
          epi(row_off + tm * 32 + row, tn * 64 + c4, sum); }
        __syncthreads();
    }
}

constexpr int NPH = 2 + 12 * DEPTH + 1;
__global__ void __launch_bounds__(512, 2) fwd_kernel(Args a_) {
    extern __shared__ __attribute__((aligned(16))) unsigned char lds_raw[];
    LAS unsigned char* lds = (LAS unsigned char*)lds_raw;
    cg::grid_group grid = cg::this_grid();
    const int ph_lo = a_.ph_lo, ph_hi = a_.ph_hi;
    volatile LAS unsigned* MISC = (volatile LAS unsigned*)(lds + 131072 + 320);
    if (threadIdx.x < 2) MISC[threadIdx.x] = 0u;
    __syncthreads();
    XcdBarrier bar; bar.bar = (unsigned*)a_.ws; bar.x = 0; bar.st = MISC;
    for (int ph = ph_lo; ph < ph_hi; ++ph) {
        if (ph == ph_lo + 1) { grid.sync(); bar = xcd_barrier_post((unsigned*)a_.ws, MISC); }
        else if (ph > ph_lo + 1) xcd_barrier(bar);
        ArgsP a = (ArgsP)__builtin_amdgcn_kernarg_segment_ptr(); asm volatile("" : "+s"(a));
        int tid = threadIdx.x; asm volatile("" : "+v"(tid));
        int bx = blockIdx.x, G = gridDim.x; asm volatile("" : "+s"(bx), "+s"(G));
        bf16_t* Hb = (bf16_t*)(a->ws + WS_H); bf16_t* Gb = (bf16_t*)(a->ws + WS_G); bf16_t* Zb = (bf16_t*)(a->ws + WS_Z); bf16_t* Yb = (bf16_t*)(a->ws + WS_Y);
        float* MOD = (float*)(a->ws + WS_MOD);
        if (ph == 0) { phase_prologue(a, lds, tid, G, bx); continue; }
        if (ph == 1) { pg8::Gemm g{(const bf16_t*)(a->ws + WS_SC), (const bf16_t*)(a->ws + WS_WMOD), 256, NMOD, D}; pg8::StaticOrder S; S.init(256, NMOD, G, bx);
            pg8::EpiF32Bias E{MOD, NMOD, a->in[12]}; pg8::gemm_phase<pg8::EpiF32Bias, pg8::StaticOrder, true, true>(lds, g, S, E); continue; }
        if (ph == NPH - 1) { phase_norm<true>(a, a->in[27], 0, false, tid, G, bx); continue; }
        const int l = (ph - 2) / 12, s = (ph - 2) % 12;
        unsigned char* wl = a->ws + WS_WL + (size_t)l * WL_STRIDE;
        if (s == 0 || s == 3 || s == 9) { const int sub = s == 0 ? 0 : (s == 3 ? 1 : 2); const float* nw = s == 0 ? a->in[8] : (s == 3 ? a->in[9] : a->in[10]); phase_norm<false>(a, nw + l * D, l * NMODL + 3 * sub * D, ph == 2, tid, G, bx); }
        else if (s == 1 || s == 10) { pg8::Gemm g{Hb, (const bf16_t*)(wl + (s == 1 ? WL_GU1 : WL_GU2)), MT, 2 * FF, D}; pg8::StaticOrder S; S.init(MT, 2 * FF, G, bx);
            pg8::EpiSwiGLU E{Gb, FF}; pg8::gemm_phase<pg8::EpiSwiGLU, pg8::StaticOrder, false, true>(lds, g, S, E);
            if (l < DEPTH - 1) { __syncthreads(); deferred_transposes(a, lds, l + 1, s == 1 ? 0 : 1, ((MT / 256) * (2 * FF / 256)) % G, tid, G, bx); } }
        else if (s == 2 || s == 11 || s == 8) {
            const int Kd = s == 8 ? D : FF; const bf16_t* Ad = s == 8 ? Yb : Gb; const bf16_t* Bd = (const bf16_t*)(wl + (s == 2 ? WL_D1 : (s == 11 ? WL_D2 : WL_WOUT)));
            pg8::Gemm g{Ad, Bd, MP, D, Kd}; pg8::StaticOrder S; S.init(MP, D, G, bx);
            const bool first = (l == 0 && s == 2);
            pg8::EpiResid E{a->out, first ? a->in[0] : a->out, MOD + l * NMODL + (s == 2 ? 2 : (s == 8 ? 5 : 8)) * D, NMOD, s == 8 ? 1.0f : 0.5f}; pg8::gemm_phase<pg8::EpiResid, pg8::StaticOrder, false, true>(lds, g, S, E);
            __syncthreads();
            SkResid SE{a->out, first ? a->in[1] - (size_t)MP * D : a->out, E.gate, NMOD, E.coef}; skinny_gemm(lds, Ad + (size_t)MP * Kd, Bd, D, Kd, MP, tid, bx, G, SE); }
        else if (s == 4) { pg8::Gemm g{Hb, (const bf16_t*)(wl + WL_WIN), MP, INW, D}; pg8::StaticOrder S; S.init(MP, INW, G, bx);
            pg8::EpiBf16<0> E{Zb, INW, nullptr, 0, 0, 1.f}; pg8::gemm_phase<pg8::EpiBf16<0>, pg8::StaticOrder, true, true>(lds, g, S, E);
            __syncthreads();
            SkBf16 SE{Zb, INW}; skinny_gemm(lds, Hb + (size_t)MP * D, (const bf16_t*)(wl + WL_WIN), INW, D, MP, tid, bx, G, SE); }
        else if (s == 5) phase_mix1(a, lds, l, tid, G, bx);
        else if (s == 6) phase_mix2(a, tid, G, bx);
        else phase_mix3(a, lds, l, tid, G, bx);
    }
}

extern "C" void kernel_launch(void* const* d_in, const int* in_sizes, int n_in, void* d_out, int out_size, void* d_ws, size_t ws_size, hipStream_t stream) {
    static int grid = 0;
    if (grid == 0) {
        if (n_in != 28 || (size_t)out_size != O_END || ws_size < WS_END) { fprintf(stderr, "kernel_launch: unexpected shapes (n_in %d, out %d, ws %zu); nothing launched\n", n_in, out_size, ws_size); grid = -1; return; }
        int dev = 0, cus = 0, per_cu = 0;
        if (hipGetDevice(&dev) != hipSuccess || hipDeviceGetAttribute(&cus, hipDeviceAttributeMultiprocessorCount, dev) != hipSuccess) { grid = -1; return; }
        if (hipFuncSetAttribute((const void*)fwd_kernel, hipFuncAttributeMaxDynamicSharedMemorySize, LDS_BYTES) != hipSuccess) { fprintf(stderr, "kernel_launch: hipFuncSetAttribute failed\n"); grid = -1; return; }
        if (hipOccupancyMaxActiveBlocksPerMultiprocessor(&per_cu, (const void*)fwd_kernel, 512, LDS_BYTES) != hipSuccess || per_cu < 1) fprintf(stderr, "kernel_launch: occupancy query says %d blocks per CU\n", per_cu);
        (void)hipGetLastError();
        grid = cus;
    }
    if (grid < 0) return;
    Args a{};
    for (int i = 0; i < 28; ++i) a.in[i] = (const float*)d_in[i];
    a.out = (float*)d_out; a.ws = (unsigned char*)d_ws;
#if MK_MULTI
    for (int ph = 0; ph < NPH; ++ph) { a.ph_lo = ph; a.ph_hi = ph + 1; hipLaunchKernelGGL(fwd_kernel, dim3(grid), dim3(512), LDS_BYTES, stream, a); }
#else
    a.ph_lo = 0; a.ph_hi = NPH;
    void* kargs[] = {&a};
    const hipError_t e = hipLaunchCooperativeKernel((const void*)fwd_kernel, dim3(grid), dim3(512), kargs, LDS_BYTES, stream);
    if (e != hipSuccess) fprintf(stderr, "kernel_launch: cooperative launch failed: %s (grid %d)\n", hipGetErrorString(e), grid);
#endif
}
```

```cpp
#include <hip/hip_runtime.h>
#include <hip/hip_cooperative_groups.h>
#include <cstdio>
#include <cstdint>
namespace cg = cooperative_groups;
namespace pg8 {
#define PG8_LAS __attribute__((address_space(3)))
typedef unsigned short bf16_t;
typedef short bf16x8 __attribute__((ext_vector_type(8)));
typedef float f32x4 __attribute__((ext_vector_type(4)));
typedef unsigned u32x4 __attribute__((ext_vector_type(4)));
constexpr int BM = 256, BK = 64, HALF = 128, HTB = HALF * BK * 2  , STAGE_BYTES = 8 * HTB, NXCD = 8, WGM = 8;

__host__ __device__ __forceinline__ int lds_byte(int r, int c) { const int st = (r >> 4) * 2 + (c >> 5), rr = r & 15, cc = c & 31, ob = rr * 64 + cc * 2; return st * 1024 + (ob ^ (((ob >> 9) & 1) << 5)); }
__host__ __device__ __forceinline__ void stage_rc(int b, int& R, int& C) { const int st = b / 1024, sb = b % 1024, swz = sb ^ (((sb >> 9) & 1) << 5); R = (st >> 1) * 16 + swz / 64; C = (st & 1) * 32 + (swz % 64) / 2; }
__host__ __device__ __forceinline__ int perm32(int rho) { const int n = rho >> 4, i = rho & 15; return 8 * (i >> 2) + 4 * n + (i & 3); }

struct Unit { int pm, pn; };
struct Gemm { const bf16_t* A; const bf16_t* Bt; int M, N, K; };

struct StaticOrder {
    int nM, nN, nwg, G, c;
    __host__ __device__ void init(int M, int N, int G_, int c_) { nM = M / BM; nN = N / BM; nwg = nM * nN; G = G_; c = c_; }
    __host__ __device__ bool next(int i, Unit& u) const {
        const long L = (long)i * G + c; if (L >= nwg) return false;
        int wgid = (int)L; { const int q = nwg / NXCD, r = nwg % NXCD, xcd = wgid % NXCD, off = wgid / NXCD; wgid = (xcd < r ? xcd * (q + 1) : r * (q + 1) + (xcd - r) * q) + off; }
        const int nig = WGM * nN, gid = wgid / nig, fm = gid * WGM, gsz = (nM - fm) < WGM ? (nM - fm) : WGM;
        u.pm = fm + ((wgid % nig) % gsz); u.pn = (wgid % nig) / gsz; return true;
    }
    __device__ __forceinline__ void a_ready(const Unit&) const {}
    __device__ __forceinline__ void done(const Unit&) const {}
};

__device__ __forceinline__ unsigned cvt_pk_bf16(float lo, float hi) { unsigned r; asm volatile("v_cvt_pk_bf16_f32 %0, %1, %2" : "=v"(r) : "v"(lo), "v"(hi)); return r; }
typedef float f32x2 __attribute__((ext_vector_type(2)));
__device__ __forceinline__ f32x2 gelu_pk(f32x2 v) {
    const f32x2 av = __builtin_elementwise_abs(v), d = av * 0.2316418882f + 1.0f;
    f32x2 t; t.x = __builtin_amdgcn_rcpf(d.x); t.y = __builtin_amdgcn_rcpf(d.y);
    f32x2 q = t * 0.5307027145f + (-0.7265760135f); q = q * t + 0.7107068705f; q = q * t + (-0.142248368f); q = q * t + 0.127414796f; q = q * t;
    const f32x2 s = (v * v) * (-0.72134752044f);
    f32x2 e; e.x = __builtin_amdgcn_exp2f(s.x); e.y = __builtin_amdgcn_exp2f(s.y);
    const f32x2 m = v * (q * e), r = v - m;
    f32x2 o; o.x = v.x < 0.f ? m.x : r.x; o.y = v.y < 0.f ? m.y : r.y; return o;
}

template <int ACT  > struct EpiBf16 {
    static constexpr bool PERM = true, AFTER_DRAIN = false; static_assert(ACT == 0 || ACT == 1, "EpiBf16: ACT is 0 (none) or 1 (gelu_pk)");
    bf16_t* O; int ldc; const float* bias; int split_cols; size_t split_stride; float scale0;
    __device__ __forceinline__ void operator()(const f32x4 (&acc)[2][2][4][2], const Unit& u, int wr, int wc, int fr, int fq) const {
        const int row0 = u.pm * BM + wr * 64 + fr; int colt = u.pn * BM; bf16_t* base = O;
        float sc = 1.f; if (split_cols) { const int t = colt / split_cols; base += (size_t)t * split_stride; colt -= t * split_cols; if (t == 0) sc = scale0; }
        const int col0 = colt + wc * 32 + 8 * fq, bcol0 = u.pn * BM + wc * 32 + 8 * fq;
        f32x4 bv[2][2];
#pragma unroll
        for (int bj = 0; bj < 2; ++bj)
#pragma unroll
            for (int n = 0; n < 2; ++n) bv[bj][n] = bias ? *(const f32x4*)(bias + bcol0 + bj * HALF + 4 * n) : (f32x4){0.f, 0.f, 0.f, 0.f};
#pragma unroll
        for (int ai = 0; ai < 2; ++ai)
#pragma unroll
            for (int m = 0; m < 4; ++m) { bf16_t* rowp = base + (size_t)(row0 + ai * HALF + m * 16) * ldc + col0;
#pragma unroll
                for (int bj = 0; bj < 2; ++bj) { f32x4 v0 = acc[ai][bj][m][0] + bv[bj][0], v1 = acc[ai][bj][m][1] + bv[bj][1];
                    if (ACT == 1) { f32x2 a = gelu_pk((f32x2){v0[0], v0[1]}), b = gelu_pk((f32x2){v0[2], v0[3]}), c = gelu_pk((f32x2){v1[0], v1[1]}), d = gelu_pk((f32x2){v1[2], v1[3]});
                        v0 = (f32x4){a.x, a.y, b.x, b.y}; v1 = (f32x4){c.x, c.y, d.x, d.y}; }
                    v0 = v0 * sc; v1 = v1 * sc; u32x4 w; w.x = cvt_pk_bf16(v0[0], v0[1]); w.y = cvt_pk_bf16(v0[2], v0[3]); w.z = cvt_pk_bf16(v1[0], v1[1]); w.w = cvt_pk_bf16(v1[2], v1[3]);
                    *(u32x4*)(rowp + bj * HALF) = w; } }
    }
};
__device__ __forceinline__ float silu_fast(float x) { return x * __builtin_amdgcn_rcpf(1.0f + __expf(-x)); }
__device__ __forceinline__ int row_batch(int row) { return row < 16384 ? (row >> 11) : 8 + ((row - 16384) >> 2); }
struct EpiSwiGLU {
    static constexpr bool PERM = true, AFTER_DRAIN = false;
    bf16_t* O; int ldc;
    __device__ __forceinline__ void operator()(const f32x4 (&acc)[2][2][4][2], const Unit& u, int wr, int wc, int fr, int fq) const {
        const int row0 = u.pm * BM + wr * 64 + fr; const int col0 = u.pn * HALF + wc * 32 + 8 * fq;
#pragma unroll
        for (int ai = 0; ai < 2; ++ai)
#pragma unroll
            for (int m = 0; m < 4; ++m) { bf16_t* rowp = O + (size_t)(row0 + ai * HALF + m * 16) * ldc + col0;
                const f32x4 g0 = acc[ai][0][m][0], g1 = acc[ai][0][m][1], u0 = acc[ai][1][m][0], u1 = acc[ai][1][m][1];
                u32x4 w; w.x = cvt_pk_bf16(silu_fast(g0[0]) * u0[0], silu_fast(g0[1]) * u0[1]); w.y = cvt_pk_bf16(silu_fast(g0[2]) * u0[2], silu_fast(g0[3]) * u0[3]);
                w.z = cvt_pk_bf16(silu_fast(g1[0]) * u1[0], silu_fast(g1[1]) * u1[1]); w.w = cvt_pk_bf16(silu_fast(g1[2]) * u1[2], silu_fast(g1[3]) * u1[3]);
                *(u32x4*)rowp = w; }
    }
};
struct EpiResid {
    static constexpr bool PERM = false, AFTER_DRAIN = false;
    float* X; const float* Xin; const float* gate; int gpitch; float coef;
    __device__ __forceinline__ void operator()(const f32x4 (&acc)[2][2][4][2], const Unit& u, int wr, int wc, int fr, int fq) const {
        const int col0 = u.pn * BM + wc * 32 + 4 * fq; const float* gp = gate + (size_t)row_batch(u.pm * BM) * gpitch + col0;
        f32x4 gv[2][2];
#pragma unroll
        for (int bj = 0; bj < 2; ++bj)
#pragma unroll
            for (int n = 0; n < 2; ++n) gv[bj][n] = *(const f32x4*)(gp + bj * HALF + n * 16) * coef;
#pragma unroll
        for (int ai = 0; ai < 2; ++ai) { const size_t r0 = (size_t)(u.pm * BM + ai * HALF + wr * 64 + fr) * 1024 + col0; f32x4 xv[4][2][2];
#pragma unroll
            for (int m = 0; m < 4; ++m)
#pragma unroll
                for (int bj = 0; bj < 2; ++bj)
#pragma unroll
                    for (int n = 0; n < 2; ++n) xv[m][bj][n] = *(const f32x4*)(Xin + r0 + (size_t)m * 16 * 1024 + bj * HALF + n * 16);
#pragma unroll
            for (int m = 0; m < 4; ++m)
#pragma unroll
                for (int bj = 0; bj < 2; ++bj)
#pragma unroll
                    for (int n = 0; n < 2; ++n) *(f32x4*)(X + r0 + (size_t)m * 16 * 1024 + bj * HALF + n * 16) = xv[m][bj][n] + gv[bj][n] * acc[ai][bj][m][n]; }
    }
};
struct EpiF32Bias {
    static constexpr bool PERM = false, AFTER_DRAIN = false;
    float* O; int ldc; const float* bias;
    __device__ __forceinline__ void operator()(const f32x4 (&acc)[2][2][4][2], const Unit& u, int wr, int wc, int fr, int fq) const {
        const int col0 = u.pn * BM + wc * 32 + 4 * fq;
#pragma unroll
        for (int ai = 0; ai < 2; ++ai)
#pragma unroll
            for (int m = 0; m < 4; ++m) { const int row = u.pm * BM + ai * HALF + wr * 64 + m * 16 + fr; float* op = O + (size_t)row * ldc + col0;
#pragma unroll
                for (int bj = 0; bj < 2; ++bj)
#pragma unroll
                    for (int n = 0; n < 2; ++n) { const f32x4 b4 = *(const f32x4*)(bias + col0 + bj * HALF + n * 16); *(f32x4*)(op + bj * HALF + n * 16) = acc[ai][bj][m][n] + b4; } }
    }
};
template <class Epi, class Sched, bool ALIGN_EPI = false, bool SP2 = false>
__device__ __forceinline__ void gemm_phase(PG8_LAS unsigned char* lds, const Gemm g, const Sched& S, const Epi& E) {
    int tid_ = threadIdx.x; asm volatile("" : "+v"(tid_)); const int tid = tid_, wid = __builtin_amdgcn_readfirstlane(tid >> 6), lane = tid & 63, wr = wid >> 2, wc = wid & 3, fr = lane & 15, fq = lane >> 4;
    const int K = g.K, nt = K / BK;
    unsigned voffA[2], voffB[2];
#pragma unroll
    for (int i = 0; i < 2; ++i) { int R, C; stage_rc(tid * 16 + i * 8192, R, C); const int Rb = Epi::PERM ? ((R & ~31) + perm32(R & 31)) : R;
        voffA[i] = (unsigned)(R * K + C) * 2u; voffB[i] = (unsigned)(Rb * K + C) * 2u; }
    const size_t kstep = (size_t)(BK * 2);
    const size_t hstep = (size_t)HALF * K * 2;
    const size_t tstep = 2 * hstep;
    const unsigned ldsw = (unsigned)wid * 1024u;
    const int aoff = lds_byte(wr * 64 + fr, fq * 8), boff = lds_byte(wc * 32 + fr, fq * 8);
#define PG8_SA(b, h) (((b) * 2 + (h)) * HTB)
#define PG8_SB(b, h) ((4 + (b) * 2 + (h)) * HTB)
#define PG8_STAGE(bufoff, gbase, voff) do { _Pragma("unroll") for (int _i = 0; _i < 2; ++_i) \
        __builtin_amdgcn_global_load_lds((const unsigned*)((const char*)(gbase) + (voff)[_i]), (PG8_LAS unsigned*)(lds + (bufoff) + ldsw + _i * 8192), 16, 0, 0); } while (0)
#define PG8_LDA(dst, b, h) do { _Pragma("unroll") for (int m = 0; m < 4; ++m) _Pragma("unroll") for (int k = 0; k < 2; ++k) dst[m][k] = *(const PG8_LAS bf16x8*)(lds + PG8_SA(b, h) + aoff + m * 2048 + k * 1024); } while (0)
#define PG8_LDB(dst, b, h) do { _Pragma("unroll") for (int n = 0; n < 2; ++n) _Pragma("unroll") for (int k = 0; k < 2; ++k) dst[n][k] = *(const PG8_LAS bf16x8*)(lds + PG8_SB(b, h) + boff + n * 2048 + k * 1024); } while (0)
#define PG8_MMA(ai, bj, At, Bt) do { __builtin_amdgcn_s_setprio(1); _Pragma("unroll") for (int m = 0; m < 4; ++m) _Pragma("unroll") for (int n = 0; n < 2; ++n) _Pragma("unroll") for (int k = 0; k < 2; ++k) \
        acc[ai][bj][m][n] = __builtin_amdgcn_mfma_f32_16x16x32_bf16(Bt[n][k], At[m][k], acc[ai][bj][m][n], 0, 0, 0); __builtin_amdgcn_s_setprio(0); } while (0)
#define PG8_WAIT_V(n) asm volatile("s_waitcnt vmcnt(" #n ")" ::: "memory")
#define PG8_WAIT_L(n) asm volatile("s_waitcnt lgkmcnt(" #n ")" ::: "memory")
#define PG8_BAR __builtin_amdgcn_s_barrier()
#define PG8_SCHED __builtin_amdgcn_sched_barrier(0)
    Unit cur, nxt; int ui = 0;
    if (!S.next(0, cur)) return;
    f32x4 acc[2][2][4][2];
#pragma unroll
    for (int a = 0; a < 2; ++a)
#pragma unroll
        for (int b = 0; b < 2; ++b)
#pragma unroll
            for (int m = 0; m < 4; ++m)
#pragma unroll
                for (int n = 0; n < 2; ++n) acc[a][b][m][n] = (f32x4){0.f, 0.f, 0.f, 0.f};
    bf16x8 At[4][2], B0[2][2], B1[2][2];
    const char* cA = (const char*)g.A + (size_t)cur.pm * tstep; const char* cB = (const char*)g.Bt + (size_t)cur.pn * tstep;
    S.a_ready(cur);
    if constexpr (SP2) {
        PG8_STAGE(PG8_SB(0, 0), cB, voffB); PG8_STAGE(PG8_SB(0, 1), cB + hstep, voffB); PG8_STAGE(PG8_SA(0, 0), cA, voffA); PG8_STAGE(PG8_SA(0, 1), cA + hstep, voffA);
        if (wr == 1) PG8_BAR;
        PG8_WAIT_V(2); PG8_BAR;
        PG8_STAGE(PG8_SB(1, 0), cB + kstep, voffB); PG8_STAGE(PG8_SA(1, 0), cA + kstep, voffA); PG8_STAGE(PG8_SB(1, 1), cB + hstep + kstep, voffB);
        PG8_WAIT_V(6); PG8_BAR;
    } else {
        PG8_STAGE(PG8_SB(0, 0), cB, voffB); PG8_STAGE(PG8_SA(0, 0), cA, voffA); PG8_STAGE(PG8_SB(0, 1), cB + hstep, voffB); PG8_STAGE(PG8_SA(0, 1), cA + hstep, voffA);
        if (wr == 1) PG8_BAR;
        PG8_WAIT_V(4); PG8_BAR;
        PG8_STAGE(PG8_SB(1, 0), cB + kstep, voffB); PG8_STAGE(PG8_SA(1, 0), cA + kstep, voffA); PG8_STAGE(PG8_SB(1, 1), cB + hstep + kstep, voffB);
        PG8_WAIT_V(6); PG8_BAR;
    }
    for (;;) {
        const bool has_next = S.next(ui + 1, nxt);
        const char* nA = has_next ? (const char*)g.A + (size_t)nxt.pm * tstep : cA; const char* nB = has_next ? (const char*)g.Bt + (size_t)nxt.pn * tstep : cB;
        for (int t = 0; t < nt; t += 2) {
            const bool last = (t == nt - 2);
            const char* a1 = cA + (size_t)(t + 1) * kstep;
            const char* a2 = last ? nA : cA + (size_t)(t + 2) * kstep; const char* b2 = last ? nB : cB + (size_t)(t + 2) * kstep;
            const char* a3 = a2 + kstep; const char* b3 = b2 + kstep;
            if (last && has_next) S.a_ready(nxt);
            if constexpr (SP2) {
            PG8_LDB(B0, 0, 0); PG8_LDB(B1, 0, 1); PG8_SCHED; PG8_LDA(At, 0, 0); PG8_STAGE(PG8_SA(1, 1), a1 + hstep, voffA);
            PG8_WAIT_V(8); PG8_WAIT_L(0); PG8_BAR; PG8_MMA(0, 0, At, B0); PG8_MMA(0, 1, At, B1); PG8_BAR; PG8_SCHED;
            PG8_LDA(At, 0, 1); PG8_STAGE(PG8_SB(0, 0), b2, voffB); PG8_STAGE(PG8_SB(0, 1), b2 + hstep, voffB); PG8_STAGE(PG8_SA(0, 0), a2, voffA);
            PG8_WAIT_V(8); PG8_WAIT_L(0); PG8_BAR; PG8_MMA(1, 0, At, B0); PG8_MMA(1, 1, At, B1); PG8_BAR; PG8_SCHED;
            PG8_LDB(B0, 1, 0); PG8_LDB(B1, 1, 1); PG8_SCHED; PG8_LDA(At, 1, 0); PG8_STAGE(PG8_SA(0, 1), a2 + hstep, voffA);
            PG8_WAIT_V(8); PG8_WAIT_L(0); PG8_BAR; PG8_MMA(0, 0, At, B0); PG8_MMA(0, 1, At, B1); PG8_BAR; PG8_SCHED;
            PG8_LDA(At, 1, 1); PG8_STAGE(PG8_SB(1, 0), b3, voffB); PG8_STAGE(PG8_SB(1, 1), b3 + hstep, voffB); PG8_STAGE(PG8_SA(1, 0), a3, voffA);
            PG8_WAIT_V(8); PG8_WAIT_L(0); PG8_BAR; PG8_MMA(1, 0, At, B0); PG8_MMA(1, 1, At, B1); PG8_BAR; PG8_SCHED;
            } else {
            PG8_LDB(B0, 0, 0); PG8_SCHED; PG8_LDA(At, 0, 0); PG8_STAGE(PG8_SA(1, 1), a1 + hstep, voffA);
            PG8_WAIT_L(8); PG8_BAR; PG8_WAIT_L(0); PG8_MMA(0, 0, At, B0); PG8_BAR; PG8_SCHED;
            PG8_LDB(B1, 0, 1); PG8_STAGE(PG8_SB(0, 0), b2, voffB);
            PG8_BAR; PG8_WAIT_L(0); PG8_MMA(0, 1, At, B1); PG8_BAR;
            PG8_LDA(At, 0, 1); PG8_STAGE(PG8_SA(0, 0), a2, voffA);
            PG8_BAR; PG8_WAIT_L(0); PG8_MMA(1, 0, At, B0); PG8_BAR; PG8_SCHED;
            PG8_STAGE(PG8_SB(0, 1), b2 + hstep, voffB);
            PG8_WAIT_V(6); PG8_BAR; PG8_MMA(1, 1, At, B1); PG8_BAR;
            PG8_LDB(B0, 1, 0); PG8_SCHED; PG8_LDA(At, 1, 0); PG8_STAGE(PG8_SA(0, 1), a2 + hstep, voffA);
            PG8_WAIT_L(8); PG8_BAR; PG8_WAIT_L(0); PG8_MMA(0, 0, At, B0); PG8_BAR; PG8_SCHED;
            PG8_LDB(B1, 1, 1); PG8_STAGE(PG8_SB(1, 0), b3, voffB);
            PG8_BAR; PG8_WAIT_L(0); PG8_MMA(0, 1, At, B1); PG8_BAR;
            PG8_LDA(At, 1, 1); PG8_STAGE(PG8_SA(1, 0), a3, voffA);
            PG8_BAR; PG8_WAIT_L(0); PG8_MMA(1, 0, At, B0); PG8_BAR; PG8_SCHED;
            PG8_STAGE(PG8_SB(1, 1), b3 + hstep, voffB);
            PG8_WAIT_V(6); PG8_BAR; PG8_MMA(1, 1, At, B1); PG8_BAR;
            }
        }
        if constexpr (ALIGN_EPI) { if (wr == 0) PG8_BAR; }
        if constexpr (!Epi::AFTER_DRAIN) { E(acc, cur, wr, wc, fr, fq); S.done(cur); }
        if (!has_next) break;
#pragma unroll
        for (int a = 0; a < 2; ++a)
#pragma unroll
            for (int b = 0; b < 2; ++b)
#pragma unroll
                for (int m = 0; m < 4; ++m)
#pragma unroll
                    for (int n = 0; n < 2; ++n) acc[a][b][m][n] = (f32x4){0.f, 0.f, 0.f, 0.f};
        cur = nxt; cA = nA; cB = nB; ++ui;
        if constexpr (ALIGN_EPI) { if (wr == 1) PG8_BAR; }
    }
    PG8_WAIT_V(0);
    if constexpr (!ALIGN_EPI) { if (wr == 0) PG8_BAR; }
    PG8_BAR;
    if constexpr (Epi::AFTER_DRAIN) { E.fused(acc, cur, wr, wc, fr, fq, lds, wid, lane); S.done(cur); }
#undef PG8_SA
#undef PG8_SB
#undef PG8_STAGE
#undef PG8_LDA
#undef PG8_LDB
#undef PG8_MMA
#undef PG8_WAIT_V
#undef PG8_WAIT_L
#undef PG8_BAR
#undef PG8_SCHED
}
}
#ifndef MIXPROBE
#define MIXPROBE 0
#endif
#ifndef MK_MULTI
#define MK_MULTI 0
#endif
#define LAS __attribute__((address_space(3)))
typedef unsigned short bf16_t;
typedef short bf16x8 __attribute__((ext_vector_type(8)));
typedef float f32x4 __attribute__((ext_vector_type(4)));
typedef float f32x16 __attribute__((ext_vector_type(16)));
typedef unsigned u32x4 __attribute__((ext_vector_type(4)));
typedef unsigned u32x2 __attribute__((ext_vector_type(2)));
typedef float f32x2 __attribute__((ext_vector_type(2)));
#define LDS_WAIT() asm volatile("s_waitcnt lgkmcnt(0)" ::: "memory")

constexpr int D = 1024, TP = 2048, MP = 16384, MS = 512, MT = MP + MS;
constexpr int FF = 2816, INW = 2048, NMODL = 9216, NMOD = 4 * NMODL, DEPTH = 4;
constexpr int OFF_HQ = 256, OFF_HF = 512, OFF_HI = 768, OFF_HG = 1024, OFF_AQ = 1280, OFF_AK = 1792, OFF_AV = 1920;
constexpr int HL = 32, HNC = TP / HL;
constexpr float EPS = 1e-6f;
constexpr int LDS_BYTES = 147456;
constexpr size_t O_Y = 0, O_POOLP = 17301504, O_HGP = 17424384, O_KP = 17948672, O_VP = 18472960, O_POOLS = 18997248, O_HGS = 20963328, O_KS = 29351936, O_VS = 37740544, O_END = 46129152;
constexpr size_t MiB = 1u << 20;
constexpr size_t WS_LBS = 1 * MiB, WS_SC = 2 * MiB, WS_WMOD = 4 * MiB, WS_WL = 76 * MiB, WL_STRIDE = 39 * MiB;
constexpr size_t WL_GU1 = 0, WL_D1 = 11 * MiB, WL_WIN = 16 * MiB + MiB / 2, WL_WOUT = 20 * MiB + MiB / 2, WL_GU2 = 22 * MiB + MiB / 2, WL_D2 = 33 * MiB + MiB / 2;
constexpr size_t WS_MOD = 232 * MiB, WS_H = 268 * MiB, WS_G = 301 * MiB, WS_Z = 301 * MiB, WS_Y = 367 * MiB, WS_HU = 400 * MiB, WS_HP = 432 * MiB, WS_END = 434 * MiB;
static_assert(WL_D2 + (size_t)D * FF * 2 <= WL_STRIDE && WS_WL + 4 * WL_STRIDE <= WS_MOD && WS_MOD + (size_t)256 * NMOD * 4 <= WS_H && WS_H + (size_t)MT * D * 2 <= WS_G, "ws map");
static_assert(WS_G + (size_t)MT * FF * 2 <= WS_HU && WS_Z + (size_t)MT * INW * 2 <= WS_Y && WS_Y + (size_t)MT * D * 2 <= WS_HU && WS_HU + (size_t)32 * HNC * 4096 * 4 <= WS_HP, "ws map 2");

__constant__ unsigned char c_bucket[128] = {0, 1, 2, 3, 4, 5, 6, 7, 8, 9, 10, 11, 12, 13, 14, 15, 16, 16, 16, 17, 17, 18, 18, 18, 19, 19, 19, 20, 20, 20, 20, 21, 21, 21, 21, 22, 22, 22, 22, 22, 23, 23, 23, 23, 23, 23, 24, 24, 24, 24, 24, 24, 25, 25, 25, 25, 25, 25, 25, 26, 26, 26, 26, 26, 26, 26, 26, 27, 27, 27, 27, 27, 27, 27, 27, 27, 27, 28, 28, 28, 28, 28, 28, 28, 28, 28, 28, 29, 29, 29, 29, 29, 29, 29, 29, 29, 29, 29, 29, 30, 30, 30, 30, 30, 30, 30, 30, 30, 30, 30, 30, 30, 30, 31, 31, 31, 31, 31, 31, 31, 31, 31, 31, 31, 31, 31, 31, 31};

__device__ __forceinline__ unsigned pk2(float lo, float hi) { unsigned r; asm("v_cvt_pk_bf16_f32 %0, %1, %2" : "=v"(r) : "v"(lo), "v"(hi)); return r; }
__device__ __forceinline__ unsigned f2bf(float f) { return pk2(f, 0.0f) & 0xffffu; }
__device__ __forceinline__ float bf2f(unsigned u) { return __builtin_bit_cast(float, u << 16); }
__device__ __forceinline__ float silu_p(float x) { return x * __builtin_amdgcn_rcpf(1.0f + __expf(-x)); }
template <int CTRL> __device__ __forceinline__ float dpp_f(float x) { return __builtin_bit_cast(float, __builtin_amdgcn_update_dpp(0, __builtin_bit_cast(int, x), CTRL, 0xf, 0xf, true)); }
__device__ __forceinline__ float wave_sum(float v) {
    v += dpp_f<0xB1>(v); v += dpp_f<0x4E>(v); v += dpp_f<0x141>(v); v += dpp_f<0x140>(v);
    v += __shfl_xor(v, 16); v += __shfl_xor(v, 32);
    return v;
}
__device__ __forceinline__ float wave_max(float v) {
#pragma unroll
    for (int o = 1; o < 64; o <<= 1) v = fmaxf(v, __shfl_xor(v, o));
    return v;
}

struct Args { const float* in[28]; float* out; unsigned char* ws; int ph_lo, ph_hi; };
typedef const __attribute__((address_space(4))) Args* ArgsP;

#define XB_TMO      128
#define XB_XCNT(j)  (256  + 64 * (j))
#define XB_XSUB(j)  (1280 + 64 * (j))
#define XB_XGEN(j)  (2304 + 64 * (j))
#define XB_TOP      3328
#define XB_TOPGEN   3392
#define XCD_BAR_WORDS 3456
#define XB_SPIN_CAP (1u << 18)

__device__ __forceinline__ unsigned xb_ld(unsigned* p)              { return __hip_atomic_load(p, __ATOMIC_RELAXED, __HIP_MEMORY_SCOPE_AGENT); }
__device__ __forceinline__ unsigned xb_add(unsigned* p, unsigned v) { return __hip_atomic_fetch_add(p, v, __ATOMIC_RELAXED, __HIP_MEMORY_SCOPE_AGENT); }
__device__ __forceinline__ unsigned xb_xcc_id() { return (unsigned)__builtin_amdgcn_s_getreg((3 << 11) | 20) & 0xFu; }
#define XB_SPIN(cond, bar) do { unsigned _sp = 0; while (cond) { __builtin_amdgcn_s_sleep(1); \
    if ((++_sp & 255u) == 0u) { if (xb_ld(&(bar)[XB_TMO])) break; if (_sp > XB_SPIN_CAP) { atomicAdd(&(bar)[XB_TMO], 1u); break; } } } } while (0)

struct XcdBarrier {
    unsigned* bar; unsigned x;
    volatile LAS unsigned* st;
};

__device__ __forceinline__ XcdBarrier xcd_barrier_post(unsigned* bar, volatile LAS unsigned* st) {
    XcdBarrier b; b.bar = bar; b.x = xb_xcc_id(); b.st = st;
    if (threadIdx.x == 0) (void)xb_add(&bar[XB_XCNT(b.x)], 1u);
    return b;
}
__device__ __forceinline__ void xcd_barrier_complete(unsigned* bar, unsigned x, unsigned& nloc, unsigned& nx) {
    const unsigned G = gridDim.x * gridDim.y * gridDim.z;
    unsigned sum, cnt, mine, sp = 0u;
    for (;;) {
        sum = 0u; cnt = 0u; mine = 0u;
#pragma unroll
        for (unsigned j = 0; j < 16; ++j) { const unsigned c = xb_ld(&bar[XB_XCNT(j)]); sum += c; cnt += (c > 0u) ? 1u : 0u; mine = (j == x) ? c : mine; }
        if (sum == G) break;
        __builtin_amdgcn_s_sleep(1);
        if ((++sp & 255u) == 0u) { if (xb_ld(&bar[XB_TMO])) break; if (sp > XB_SPIN_CAP) { atomicAdd(&bar[XB_TMO], 1u); break; } }
    }
    nloc = mine > 0u ? mine : 1u; nx = cnt > 0u ? cnt : 1u;
}

__device__ __forceinline__ void xcd_barrier(const XcdBarrier& b) {
    asm volatile("s_waitcnt vmcnt(0)" ::: "memory");
    __syncthreads();
    if (threadIdx.x == 0) {
        unsigned* bar = b.bar;
        __builtin_amdgcn_s_waitcnt(0);
        unsigned nloc = b.st[0], nx = b.st[1];
        if (nloc == 0u) { xcd_barrier_complete(bar, b.x, nloc, nx); b.st[0] = nloc; b.st[1] = nx; }
        const unsigned old = xb_add(&bar[XB_XSUB(b.x)], 1u);
        const unsigned gen = old / nloc;
        if (old + 1u == (gen + 1u) * nloc) {
            __builtin_amdgcn_fence(__ATOMIC_RELEASE, "agent");
            asm volatile("s_waitcnt vmcnt(0)" ::: "memory");
            const unsigned og = xb_add(&bar[XB_TOP], 1u);
            const unsigned tg = og / nx;
            if (og + 1u == (tg + 1u) * nx) xb_add(&bar[XB_TOPGEN], 1u);
            else XB_SPIN(xb_ld(&bar[XB_TOPGEN]) == tg, bar);
            __builtin_amdgcn_fence(__ATOMIC_ACQUIRE, "agent");
            xb_add(&bar[XB_XGEN(b.x)], 1u);
            asm volatile("s_waitcnt vmcnt(0)" ::: "memory");
        } else {
            XB_SPIN(xb_ld(&bar[XB_XGEN(b.x)]) == gen, bar);
            __builtin_amdgcn_fence(__ATOMIC_ACQUIRE, "agent");
            asm volatile("s_waitcnt vmcnt(0)" ::: "memory");
        }
    }
    __syncthreads();
}

__device__ __forceinline__ void transpose_item(const float* W, int K, int N, bf16_t* WT, int rstride, int roff, LAS float* scr, int item, int lane) {
    const int nblk = N / 32, kb = item / nblk, nb = item % nblk, k0 = 64 * kb, n0 = 32 * nb;
    float tv[32];
#pragma unroll
    for (int i = 0; i < 32; ++i) { const int kk = 2 * i + (lane >> 5); tv[i] = W[(size_t)(k0 + kk) * N + n0 + (lane & 31)]; }
#pragma unroll
    for (int i = 0; i < 32; ++i) { const int kk = 2 * i + (lane >> 5); scr[kk * 33 + (lane & 31)] = tv[i]; }
    LDS_WAIT();
    const int c = lane & 7;
#pragma unroll
    for (int j = 0; j < 4; ++j) { const int n = (lane >> 3) + 8 * j; const LAS float* s = scr + (8 * c) * 33 + n;
        u32x4 o; o.x = pk2(s[0 * 33], s[1 * 33]); o.y = pk2(s[2 * 33], s[3 * 33]); o.z = pk2(s[4 * 33], s[5 * 33]); o.w = pk2(s[6 * 33], s[7 * 33]);
        const int nn = n0 + n, drow = (nn >> 7) * rstride + (nn & 127) + roff;
        *(u32x4*)(WT + (size_t)drow * K + k0 + 8 * c) = o; }
    LDS_WAIT();
}
constexpr int I_GU = 16 * 88, I_DN = 44 * 32, I_IN = 16 * 64, I_OUT = 16 * 32, I_MOD = 16 * 288, I_LW = 6 * I_GU + I_IN + I_OUT;
static_assert(I_GU == I_DN, "items");
constexpr int I_DEF = 2752;
__device__ __forceinline__ void transpose_layer_item(ArgsP a, int l, int r, LAS float* scr, int lane) {
    unsigned char* wl = a->ws + WS_WL + (size_t)l * WL_STRIDE;
    const float* src; bf16_t* dst; int K = D, N = FF, rs = 256, ro = 0;
    if (r < 0) { r += I_MOD; src = a->in[11] + (size_t)l * D * NMODL; dst = (bf16_t*)(a->ws + WS_WMOD) + (size_t)l * NMODL * D; N = NMODL; rs = 128; }
    else if (r < I_GU) { src = a->in[13] + (size_t)l * D * FF; dst = (bf16_t*)(wl + WL_GU1); }
    else if (r < 2 * I_GU) { r -= I_GU; src = a->in[14] + (size_t)l * D * FF; dst = (bf16_t*)(wl + WL_GU1); ro = 128; }
    else if (r < 3 * I_GU) { r -= 2 * I_GU; src = a->in[15] + (size_t)l * FF * D; dst = (bf16_t*)(wl + WL_D1); K = FF; N = D; rs = 128; }
    else if (r < 3 * I_GU + I_IN) { r -= 3 * I_GU; src = a->in[16] + (size_t)l * D * INW; dst = (bf16_t*)(wl + WL_WIN); N = INW; rs = 128; }
    else if (r < 3 * I_GU + I_IN + I_OUT) { r -= 3 * I_GU + I_IN; src = a->in[17] + (size_t)l * D * D; dst = (bf16_t*)(wl + WL_WOUT); N = D; rs = 128; }
    else if (r < 4 * I_GU + I_IN + I_OUT) { r -= 3 * I_GU + I_IN + I_OUT; src = a->in[24] + (size_t)l * D * FF; dst = (bf16_t*)(wl + WL_GU2); }
    else if (r < 5 * I_GU + I_IN + I_OUT) { r -= 4 * I_GU + I_IN + I_OUT; src = a->in[25] + (size_t)l * D * FF; dst = (bf16_t*)(wl + WL_GU2); ro = 128; }
    else { r -= 5 * I_GU + I_IN + I_OUT; src = a->in[26] + (size_t)l * FF * D; dst = (bf16_t*)(wl + WL_D2); K = FF; N = D; rs = 128; }
    transpose_item(src, K, N, dst, rs, ro, scr, r, lane);
}
__device__ __forceinline__ void deferred_transposes(ArgsP a, LAS unsigned char* lds, int l_next, int half, int first_idle, int tid, int G, int bx) {
    if (bx < first_idle) return;
    const int wave = tid >> 6, lane = tid & 63, wv = (bx - first_idle) * 8 + wave, NW = (G - first_idle) * 8;
    LAS float* scr = (LAS float*)(lds + wave * 16384);
    for (int it = half * (I_LW / 2) + wv; it < half * (I_LW / 2) + I_DEF; it += NW) transpose_layer_item(a, l_next, it, scr, lane);
}
__device__ __forceinline__ void phase_prologue(ArgsP a, LAS unsigned char* lds, int tid, int G, int bx) {
    const int wave = tid >> 6, lane = tid & 63, gw = bx * 8 + wave, NGW = G * 8;
    LAS float* scr = (LAS float*)(lds + wave * 16384);
    constexpr int I_REST = I_LW / 2 - I_DEF, N_A = DEPTH * I_MOD, N_B = N_A + I_LW, N_C = N_B + 3 * 2 * I_REST;
    for (int it = gw; it < N_C; it += NGW) { int l, r;
        if (it < N_A) { l = it / I_MOD; r = it % I_MOD - I_MOD; }
        else if (it < N_B) { l = 0; r = it - N_A; }
        else { const int q = it - N_B, lh = q / I_REST; l = 1 + (lh >> 1); r = (lh & 1) * (I_LW / 2) + I_DEF + q % I_REST; }
        transpose_layer_item(a, l, r, scr, lane); }
    const int gt = bx * 512 + tid, NT = G * 512;
    bf16_t* SC = (bf16_t*)(a->ws + WS_SC);
    for (int i = gt; i < 256 * D; i += NT) { const int r = i >> 10, d = i & 1023; float v = 0.f;
        if (r < 8) v = silu_p(a->in[2][r * D + d]); else if (r < 136) v = silu_p(a->in[3][(r - 8) * D + d]);
        SC[i] = (bf16_t)f2bf(v); }
    if (bx == 0) { unsigned* bw = (unsigned*)a->ws; for (int i = tid; i < XCD_BAR_WORDS; i += 512) bw[i] = 0u; }
    if (bx == 0 && tid < 256) { float* LBS = (float*)(a->ws + WS_LBS); const float* hl = a->in[20];
        const float a0 = hl[tid], a1 = hl[256 + tid], a2 = hl[512 + tid], a3 = hl[768 + tid]; const float mx = fmaxf(fmaxf(a0, a1), fmaxf(a2, a3));
        const float e0 = expf(a0 - mx), e1 = expf(a1 - mx), e2 = expf(a2 - mx), e3 = expf(a3 - mx), s = e0 + e1 + e2 + e3;
        LBS[tid] = 0.f; LBS[256 + tid] = e1 / s; LBS[512 + tid] = (e1 + e2) / s; LBS[768 + tid] = (e1 + e2 + e3) / s; }
}

template <bool FINAL>
__device__ __forceinline__ void phase_norm(ArgsP a, const float* nw, int modcol, bool first, int tid, int G, int bx) {
    const int wave = tid >> 6, lane = tid & 63, gw = bx * 8 + wave, NGW = G * 8;
    float* X = a->out; bf16_t* H = (bf16_t*)(a->ws + WS_H); const float* MOD = (const float*)(a->ws + WS_MOD);
    f32x4 nv[4];
#pragma unroll
    for (int j = 0; j < 4; ++j) nv[j] = ((const f32x4*)nw)[lane + 64 * j];
    for (int row = 2 * gw; row < MT; row += 2 * NGW) {
        f32x4* xr = (f32x4*)(X + (size_t)row * D) + lane; f32x4 v[2][4]; float s0 = 0.f, s1 = 0.f;
        const f32x4* xs = first ? (const f32x4*)(row < MP ? a->in[0] + (size_t)row * D : a->in[1] + (size_t)(row - MP) * D) + lane : xr;
#pragma unroll
        for (int j = 0; j < 4; ++j) { v[0][j] = xs[64 * j]; v[1][j] = xs[256 + 64 * j]; }
        f32x4 sh[4], sc[4];
        if (!FINAL) { const float* mp = MOD + (size_t)pg8::row_batch(row) * NMOD + modcol;
#pragma unroll
            for (int j = 0; j < 4; ++j) { sh[j] = ((const f32x4*)mp)[lane + 64 * j]; sc[j] = ((const f32x4*)(mp + D))[lane + 64 * j]; } }
#pragma unroll
        for (int j = 0; j < 4; ++j) { s0 += (v[0][j].x * v[0][j].x + v[0][j].y * v[0][j].y) + (v[0][j].z * v[0][j].z + v[0][j].w * v[0][j].w);
            s1 += (v[1][j].x * v[1][j].x + v[1][j].y * v[1][j].y) + (v[1][j].z * v[1][j].z + v[1][j].w * v[1][j].w); }
        s0 = wave_sum(s0); s1 = wave_sum(s1);
        const float r0 = __builtin_amdgcn_rsqf(s0 * (1.0f / D) + EPS), r1 = __builtin_amdgcn_rsqf(s1 * (1.0f / D) + EPS);
        if (FINAL) {
#pragma unroll
            for (int j = 0; j < 4; ++j) { xr[64 * j] = (v[0][j] * r0) * nv[j]; xr[256 + 64 * j] = (v[1][j] * r1) * nv[j]; }
        } else {
            unsigned long long* o8 = (unsigned long long*)(H + (size_t)row * D) + lane;
#pragma unroll
            for (int j = 0; j < 4; ++j) { const f32x4 c = nv[j] * (sc[j] + 1.0f);
                const f32x4 h0 = ((v[0][j] * r0) * nv[j]) * (sc[j] + 1.0f) + sh[j], h1 = ((v[1][j] * r1) * nv[j]) * (sc[j] + 1.0f) + sh[j]; (void)c;
                o8[64 * j] = (unsigned long long)pk2(h0.x, h0.y) | ((unsigned long long)pk2(h0.z, h0.w) << 32);
                o8[256 + 64 * j] = (unsigned long long)pk2(h1.x, h1.y) | ((unsigned long long)pk2(h1.z, h1.w) << 32); }
        }
    }
}

__device__ __forceinline__ void attn_prompt_item(LAS unsigned char* lds, const bf16_t* Z, bf16_t* Y, const float* sinks, const float* relb, int item, int tid) {
    const int b = item >> 6, qblk = (item >> 1) & 31, kvh = item & 1, q0 = qblk * 64, rowbase = b * TP;
    LAS unsigned char* Ks = lds;
    LAS bf16_t* Vt = (LAS bf16_t*)(lds + 27648);
    LAS float* tab = (LAS float*)(lds + 27648 + 25088);
    const int w = tid >> 6, lane = tid & 63, hl = w >> 1, qsub = w & 1, head = kvh * 4 + hl, r = lane & 31, hi = lane >> 5;
    const int qi = qsub * 32 + r; const size_t qrow = (size_t)rowbase + q0 + qi;
    bf16x8 qf[4];
#pragma unroll
    for (int s = 0; s < 4; ++s) qf[s] = *(const bf16x8*)(Z + qrow * INW + OFF_AQ + head * 64 + 16 * s + 8 * hi);
    u32x4 kv[3], vv[3];
#pragma unroll
    for (int i = 0; i < 3; ++i) { const int ch = tid + i * 512, key = ch >> 3, c8 = ch & 7, kp = max(q0 - 128 + key, 0);
        const bf16_t* zr = Z + (size_t)(rowbase + kp) * INW + kvh * 64 + c8 * 8; kv[i] = *(const u32x4*)(zr + OFF_AK); vv[i] = *(const u32x4*)(zr + OFF_AV); }
#pragma unroll
    for (int i = 0; i < 3; ++i) {
        const int ch = tid + i * 512, key = ch >> 3, c8 = ch & 7;
        if (q0 - 128 + key < 0) { kv[i] = (u32x4){0u, 0u, 0u, 0u}; vv[i] = (u32x4){0u, 0u, 0u, 0u}; }
        *(LAS u32x4*)(Ks + key * 144 + c8 * 16) = kv[i];
#pragma unroll
        for (int e = 0; e < 8; ++e) Vt[(c8 * 8 + e) * 196 + key] = (bf16_t)((vv[i][e >> 1] >> (16 * (e & 1))) & 0xffffu);
    }
    { const int hl = tid >> 7, n = tid & 127; tab[tid] = relb[(int)c_bucket[n] * 8 + kvh * 4 + hl]; }
    __syncthreads();
    const float sink = sinks[head]; const unsigned nlim = (unsigned)min(127, q0 + qi);
    float mx = -INFINITY;
#pragma unroll 1
    for (int tt = 0; tt < 5; ++tt) { f32x16 acc;
#pragma unroll
        for (int i = 0; i < 16; ++i) acc[i] = 0.f;
        const LAS unsigned char* kb = Ks + ((qsub + tt) * 32 + r) * 144 + 16 * hi;
#pragma unroll
        for (int s = 0; s < 4; ++s) { const bf16x8 kf = *(const LAS bf16x8*)(kb + 32 * s); acc = __builtin_amdgcn_mfma_f32_32x32x16_bf16(kf, qf[s], acc, 0, 0, 0); }
        const int nb = r + 128 - tt * 32 - 4 * hi; const LAS float* tb = tab + hl * 128;
#pragma unroll
        for (int i = 0; i < 16; ++i) { const int n = nb - ((i & 3) + 8 * (i >> 2));
            const float lg = acc[i] * 0.125f + tb[n & 127]; mx = fmaxf(mx, ((unsigned)n <= nlim) ? lg : -INFINITY); } }
    mx = fmaxf(mx, __shfl_xor(mx, 32)); mx = fmaxf(mx, sink);
    float sum = 0.f;
    f32x16 oacc[2];
#pragma unroll
    for (int dt = 0; dt < 2; ++dt)
#pragma unroll
        for (int i = 0; i < 16; ++i) oacc[dt][i] = 0.f;
#pragma unroll 1
    for (int tt = 0; tt < 5; ++tt) { f32x16 acc;
#pragma unroll
        for (int i = 0; i < 16; ++i) acc[i] = 0.f;
        const LAS unsigned char* kb = Ks + ((qsub + tt) * 32 + r) * 144 + 16 * hi;
#pragma unroll
        for (int s = 0; s < 4; ++s) { const bf16x8 kf = *(const LAS bf16x8*)(kb + 32 * s); acc = __builtin_amdgcn_mfma_f32_32x32x16_bf16(kf, qf[s], acc, 0, 0, 0); }
        const int nb = r + 128 - tt * 32 - 4 * hi; const LAS float* tb = tab + hl * 128;
#pragma unroll
        for (int i = 0; i < 16; ++i) { const int n = nb - ((i & 3) + 8 * (i >> 2));
            const float lg = acc[i] * 0.125f + tb[n & 127]; const float p = ((unsigned)n <= nlim) ? __expf(lg - mx) : 0.f; acc[i] = p; sum += p; }
#pragma unroll
        for (int s = 0; s < 2; ++s) {
            u32x4 pw; pw.x = pk2(acc[8 * s + 0], acc[8 * s + 1]); pw.y = pk2(acc[8 * s + 2], acc[8 * s + 3]); pw.z = pk2(acc[8 * s + 4], acc[8 * s + 5]); pw.w = pk2(acc[8 * s + 6], acc[8 * s + 7]);
            const bf16x8 pf = __builtin_bit_cast(bf16x8, pw);
#pragma unroll
            for (int dt = 0; dt < 2; ++dt) { const LAS bf16_t* vp = Vt + (dt * 32 + r) * 196 + (qsub + tt) * 32 + 16 * s + 4 * hi;
                const u32x2 lo = *(const LAS u32x2*)vp, hh = *(const LAS u32x2*)(vp + 8); u32x4 vw; vw.x = lo.x; vw.y = lo.y; vw.z = hh.x; vw.w = hh.y;
                oacc[dt] = __builtin_amdgcn_mfma_f32_32x32x16_bf16(__builtin_bit_cast(bf16x8, vw), pf, oacc[dt], 0, 0, 0); }
        } }
    sum += __shfl_xor(sum, 32);
    const float inv = __builtin_amdgcn_rcpf(sum + __expf(sink - mx));
    bf16_t* yr = Y + qrow * D + 512 + head * 64;
#pragma unroll
    for (int dt = 0; dt < 2; ++dt)
#pragma unroll
        for (int g4 = 0; g4 < 4; ++g4) { u32x2 o; o.x = pk2(oacc[dt][4 * g4 + 0] * inv, oacc[dt][4 * g4 + 1] * inv); o.y = pk2(oacc[dt][4 * g4 + 2] * inv, oacc[dt][4 * g4 + 3] * inv);
            *(u32x2*)(yr + dt * 32 + 8 * g4 + 4 * hi) = o; }
    __syncthreads();
}
__device__ __forceinline__ void attn_sample_item(LAS unsigned char* lds, ArgsP a, int l, const bf16_t* Z, bf16_t* Y, const float* sinks, const float* relb, int item, int tid) {
    const int b = item >> 1, kvh = item & 1;
    LAS float* Kx = (LAS float*)lds;
    LAS float* Vx = (LAS float*)(lds + 35904);
    LAS float* Qs = (LAS float*)(lds + 69696);
    LAS float* Ps = (LAS float*)(lds + 73792);
    LAS float* tab = (LAS float*)(lds + 82496);
    const size_t cbase = (size_t)(l * 128 + b) * 128 * 128;
    const float* ck = a->in[6] + cbase; const float* cv = a->in[7] + cbase; float* nk = a->out + O_KS + cbase; float* nv = a->out + O_VS + cbase;
    { float kx[16], vx[16]; const int d = tid & 63, j0 = tid >> 6;
#pragma unroll
      for (int i = 0; i < 16; ++i) { kx[i] = ck[(j0 + 8 * i) * 128 + kvh * 64 + d]; vx[i] = cv[(j0 + 8 * i) * 128 + kvh * 64 + d]; }
      unsigned zk = 0, zv = 0, zq0, zq1;
      { const int t = (tid >> 6) & 3; const bf16_t* zr = Z + (size_t)(MP + b * 4 + t) * INW + kvh * 64 + d; zk = zr[OFF_AK]; zv = zr[OFF_AV]; }
      { const int rr = tid >> 6, hl = rr >> 2, t = rr & 3; zq0 = Z[(size_t)(MP + b * 4 + t) * INW + OFF_AQ + (kvh * 4 + hl) * 64 + d]; zq1 = Z[(size_t)(MP + b * 4 + t) * INW + OFF_AQ + (kvh * 4 + hl + 2) * 64 + d]; }
#pragma unroll
      for (int i = 0; i < 16; ++i) { const int j = j0 + 8 * i; Kx[j * 68 + d] = kx[i]; Vx[j * 64 + d] = vx[i];
          if (j >= 4) { nk[(j - 4) * 128 + kvh * 64 + d] = kx[i]; nv[(j - 4) * 128 + kvh * 64 + d] = vx[i]; } }
      if (tid < 256) { const int t = tid >> 6; const float k1 = bf2f(zk), v1 = bf2f(zv);
          Kx[(128 + t) * 68 + d] = k1; Vx[(128 + t) * 64 + d] = v1; nk[(124 + t) * 128 + kvh * 64 + d] = k1; nv[(124 + t) * 128 + kvh * 64 + d] = v1; }
      Qs[tid] = bf2f(zq0); Qs[tid + 512] = bf2f(zq1); }
    { const int hl = tid >> 7, n = tid & 127; tab[tid] = relb[(int)c_bucket[n] * 8 + kvh * 4 + hl]; }
    __syncthreads();
    const int w = tid >> 6, lane = tid & 63;
#pragma unroll
    for (int r2 = 0; r2 < 2; ++r2) { const int row = 2 * w + r2, hl = row >> 2, t = row & 3; const float sink = sinks[kvh * 4 + hl];
        float lg[3]; float mx = -INFINITY;
#pragma unroll
        for (int ps = 0; ps < 3; ++ps) { const int key = lane + 64 * ps; float v = -INFINITY;
            if (key < 132) { float dot = 0.f; const LAS f32x4* q4 = (const LAS f32x4*)(Qs + row * 64); const LAS f32x4* k4 = (const LAS f32x4*)(Kx + key * 68);
#pragma unroll
                for (int d = 0; d < 16; ++d) { const f32x4 qa = q4[d], ka = k4[d]; dot += (qa.x * ka.x + qa.y * ka.y) + (qa.z * ka.z + qa.w * ka.w); }
                const int n = t + 128 - key; if (n >= 0 && n < 128) v = dot * 0.125f + tab[hl * 128 + n]; }
            lg[ps] = v; mx = fmaxf(mx, v); }
        mx = fmaxf(wave_max(mx), sink);
        float p[3], sum = 0.f;
#pragma unroll
        for (int ps = 0; ps < 3; ++ps) { p[ps] = __expf(lg[ps] - mx); sum += p[ps]; }
        const float inv = __builtin_amdgcn_rcpf(wave_sum(sum) + __expf(sink - mx));
#pragma unroll
        for (int ps = 0; ps < 3; ++ps) { const int key = lane + 64 * ps; if (key < 132) Ps[row * 136 + key] = p[ps] * inv; }
        LDS_WAIT();
        float o = 0.f;
#pragma unroll 4
        for (int key = 0; key < 132; ++key) o += Ps[row * 136 + key] * Vx[key * 64 + lane];
        Y[(size_t)(MP + b * 4 + t) * D + 512 + (kvh * 4 + hl) * 64 + lane] = (bf16_t)f2bf(o);
    }
    __syncthreads();
}

__device__ __forceinline__ void pool_item(LAS unsigned char* lds, const bf16_t* Z, bf16_t* Y, const float* pw, const float* psc, bool sample, int rowbase, int t0, const float* prefix, float* newpool, int tid) {
    const int ntok = sample ? 4 : 32, nrows = ntok + 15, tph = ntok >> 1;
    LAS float* ext = (LAS float*)lds;
    LAS float* dbuf = (LAS float*)(lds + 48128);
    if (sample) {
        f32x4 p0[2], p1[2]; u32x4 zz = {0u, 0u, 0u, 0u};
#pragma unroll
        for (int k = 0; k < 2; ++k) { const int c = min(tid + k * 512, 479), i = c >> 5, c8 = c & 31; p0[k] = *(const f32x4*)(prefix + i * 256 + c8 * 8); p1[k] = *(const f32x4*)(prefix + i * 256 + c8 * 8 + 4); }
        if (tid < 128) zz = *(const u32x4*)(Z + (size_t)(rowbase + (tid >> 5)) * INW + (tid & 31) * 8);
#pragma unroll
        for (int k = 0; k < 2; ++k) { const int c = tid + k * 512; if (c < 480) { const int i = c >> 5, c8 = c & 31; *(LAS f32x4*)(ext + i * 256 + c8 * 8) = p0[k]; *(LAS f32x4*)(ext + i * 256 + c8 * 8 + 4) = p1[k]; } }
        if (tid < 128) { const int i = 15 + (tid >> 5), c8 = tid & 31; f32x4 v0, v1;
            v0.x = bf2f(zz.x & 0xffffu); v0.y = bf2f(zz.x >> 16); v0.z = bf2f(zz.y & 0xffffu); v0.w = bf2f(zz.y >> 16); v1.x = bf2f(zz.z & 0xffffu); v1.y = bf2f(zz.z >> 16); v1.z = bf2f(zz.w & 0xffffu); v1.w = bf2f(zz.w >> 16);
            *(LAS f32x4*)(ext + i * 256 + c8 * 8) = v0; *(LAS f32x4*)(ext + i * 256 + c8 * 8 + 4) = v1; }
    } else {
        u32x4 zz[3];
#pragma unroll
        for (int k = 0; k < 3; ++k) { const int c = min(tid + k * 512, 1503), i = c >> 5, c8 = c & 31, tl = max(i - 15, -t0); zz[k] = *(const u32x4*)(Z + (size_t)(rowbase + tl) * INW + c8 * 8); }
#pragma unroll
        for (int k = 0; k < 3; ++k) { const int c = tid + k * 512; if (c < 1504) { const int i = c >> 5, c8 = c & 31; u32x4 z = zz[k]; if (t0 + i - 15 < 0) z = (u32x4){0u, 0u, 0u, 0u}; f32x4 v0, v1;
            v0.x = bf2f(z.x & 0xffffu); v0.y = bf2f(z.x >> 16); v0.z = bf2f(z.y & 0xffffu); v0.w = bf2f(z.y >> 16); v1.x = bf2f(z.z & 0xffffu); v1.y = bf2f(z.z >> 16); v1.z = bf2f(z.w & 0xffffu); v1.w = bf2f(z.w >> 16);
            *(LAS f32x4*)(ext + i * 256 + c8 * 8) = v0; *(LAS f32x4*)(ext + i * 256 + c8 * 8 + 4) = v1; } }
    }
    __syncthreads();
    const int ch = tid & 255, half = tid >> 8, g = ch >> 6, wlen = 2 << g, gd = ch & 63;
    { const int tb0 = half * tph; const LAS float* ep = ext + (15 + tb0) * 256 + ch; float s = 0.f;
#pragma unroll
      for (int q = 0; q < 16; ++q) { const float v = ep[-q * 256]; s += (q < wlen) ? v : 0.f; }
#pragma unroll
      for (int tt = 0; tt < 16; ++tt) if (tt < tph) { const float cur = ep[tt * 256];
          if (tt > 0) s += cur - ep[(tt - wlen) * 256];
          const int cnt = sample ? wlen : min(t0 + tb0 + tt + 1, wlen);
          dbuf[(tb0 + tt) * 256 + ch] = s * __builtin_amdgcn_rcpf((float)cnt) - cur; } }
    if (newpool) for (int idx = tid; idx < 15 * 256; idx += 512) newpool[idx] = ext[(nrows - 15) * 256 + idx];
    __syncthreads();
    float acc[16];
#pragma unroll
    for (int tt = 0; tt < 16; ++tt) acc[tt] = 0.f;
    const float* wp = pw + (size_t)(g * 64) * 64 + gd;
    float wa0 = wp[0], wa1 = wp[64], wa2 = wp[128], wa3 = wp[192], wb0 = wp[256], wb1 = wp[320], wb2 = wp[384], wb3 = wp[448];
#pragma unroll 1
    for (int c4 = 0; c4 < 16; ++c4) {
        const float* wn = wp + (size_t)min(c4 + 2, 15) * 256; const float wc0 = wn[0], wc1 = wn[64], wc2 = wn[128], wc3 = wn[192];
        const LAS float* dp = dbuf + (half * tph) * 256 + g * 64 + c4 * 4;
#pragma unroll
        for (int tt = 0; tt < 16; ++tt) if (tt < tph) { const f32x4 d4 = *(const LAS f32x4*)(dp + tt * 256);
            acc[tt] += (d4.x * wa0 + d4.y * wa1) + (d4.z * wa2 + d4.w * wa3); }
        wa0 = wb0; wa1 = wb1; wa2 = wb2; wa3 = wb3; wb0 = wc0; wb1 = wc1; wb2 = wc2; wb3 = wc3;
    }
    const float sc = psc[ch];
#pragma unroll
    for (int tt = 0; tt < 16; ++tt) if (tt < tph) Y[(size_t)(rowbase + half * tph + tt) * D + ch] = (bf16_t)f2bf(acc[tt] * sc);
    __syncthreads();
}

template <bool OUT, int NSTEPS>
__device__ __forceinline__ void hgrn_run(LAS float* wl, const bf16_t* Z, bf16_t* Y, int row0, int h, float lbv, float hgn, f32x2 (&S)[32], float& P, int lane) {
    LAS float* fb = wl; LAS float* qb = wl + 1024; LAS unsigned* vg = (LAS unsigned*)(wl + 2048); LAS float* obuf = wl + 3072;
    const LAS f32x4* fb4 = (const LAS f32x4*)fb; const LAS f32x4* qb4 = (const LAS f32x4*)qb;
    constexpr int nst = NSTEPS < 16 ? NSTEPS : 16; static_assert(NSTEPS <= 16 || NSTEPS % 16 == 0, "steps");
    for (int t0 = 0; t0 < NSTEPS; t0 += 16) {
        unsigned rf[nst], ri[nst], rq[nst], rg[nst];
#pragma unroll
        for (int tt = 0; tt < nst; ++tt) { const bf16_t* zr = Z + (size_t)(row0 + t0 + tt) * INW + h * 64 + lane;
            rf[tt] = zr[OFF_HF]; ri[tt] = zr[OFF_HI]; if (OUT) { rq[tt] = zr[OFF_HQ]; rg[tt] = zr[OFF_HG]; } }
#pragma unroll
        for (int tt = 0; tt < nst; ++tt) {
            const float f = lbv + (1.0f - lbv) * __builtin_amdgcn_rcpf(1.0f + __expf(-bf2f(rf[tt]))); fb[tt * 64 + lane] = f; P *= f;
            unsigned pv = ri[tt];
            if (OUT) { qb[tt * 64 + lane] = silu_p(bf2f(rq[tt])); pv |= rg[tt] << 16; }
            vg[tt * 64 + lane] = pv; }
        LDS_WAIT();
        f32x4 fA[4], qA[4], fB[4], qB[4];
#pragma unroll
        for (int i = 0; i < 4; ++i) { fA[i] = fb4[i]; if (OUT) qA[i] = qb4[i]; }
#define HG_PART(FX, QX, base) _Pragma("unroll") for (int i = 0; i < 4; ++i) { const f32x2 f0 = __builtin_shufflevector(FX[i], FX[i], 0, 1), f1 = __builtin_shufflevector(FX[i], FX[i], 2, 3); \
                S[(base) + 2 * i] = f0 * (S[(base) + 2 * i] - v2) + v2; S[(base) + 2 * i + 1] = f1 * (S[(base) + 2 * i + 1] - v2) + v2; \
                if (OUT) { oa += S[(base) + 2 * i] * __builtin_shufflevector(QX[i], QX[i], 0, 1); ob += S[(base) + 2 * i + 1] * __builtin_shufflevector(QX[i], QX[i], 2, 3); } }
#define HG_LOAD(FX, QX, idx) _Pragma("unroll") for (int i = 0; i < 4; ++i) { FX[i] = fb4[(idx) + i]; if (OUT) QX[i] = qb4[(idx) + i]; }
#pragma unroll 1
        for (int tt = 0; tt < nst; ++tt) {
            const unsigned pv = vg[tt * 64 + lane]; const float v = bf2f(pv & 0xffffu); const f32x2 v2 = {v, v};
            f32x2 oa = {0.f, 0.f}, ob = {0.f, 0.f};
            const int tn = min(tt + 1, 15);
            HG_LOAD(fB, qB, tt * 16 + 4);  HG_PART(fA, qA, 0);
            HG_LOAD(fA, qA, tt * 16 + 8);  HG_PART(fB, qB, 8);
            HG_LOAD(fB, qB, tt * 16 + 12); HG_PART(fA, qA, 16);
            HG_LOAD(fA, qA, tn * 16);      HG_PART(fB, qB, 24);
            if (OUT) obuf[tt * 64 + lane] = (oa.x + oa.y) + (ob.x + ob.y);
        }
        if (OUT) {
#pragma unroll
            for (int tt = 0; tt < 16; ++tt) if (tt < nst) { const float o = obuf[tt * 64 + lane]; const float ms = wave_sum(o * o) * (1.0f / 64.0f); const float on = o * __builtin_amdgcn_rsqf(ms + EPS) * hgn;
                Y[(size_t)(row0 + t0 + tt) * D + 256 + h * 64 + lane] = (bf16_t)f2bf(on * silu_p(bf2f(vg[tt * 64 + lane] >> 16))); }
        }
#undef HG_PART
#undef HG_LOAD
        LDS_WAIT();
    }
}

__device__ __forceinline__ void phase_mix1(ArgsP a, LAS unsigned char* lds, int l, int tid, int G, int bx) {
    const bf16_t* Z = (const bf16_t*)(a->ws + WS_Z); bf16_t* Y = (bf16_t*)(a->ws + WS_Y);
    const float* sinks = a->in[22] + l * 8; const float* relb = a->in[23];
for (int rp_ = 0; rp_ < (MIXPROBE == 1 ? 2 : 1); ++rp_) {
        for (int it = bx; it < 512; it += G) attn_prompt_item(lds, Z, Y, sinks, relb, it, tid);
    }
for (int rp_ = 0; rp_ < (MIXPROBE == 2 ? 2 : 1); ++rp_) {
        for (int it = bx; it < 256; it += G) attn_sample_item(lds, a, l, Z, Y, sinks, relb, it, tid);
    }
    const float* pw = a->in[18] + (size_t)l * 4 * 64 * 64; const float* psc = a->in[19] + l * 256;
for (int rp_ = 0; rp_ < (MIXPROBE == 3 ? 2 : 1); ++rp_) {
        for (int it = bx; it < 512; it += G) { const int b = it >> 6, tb = it & 63;
        pool_item(lds, Z, Y, pw, psc, false, b * TP + tb * 32, tb * 32, nullptr, tb == 63 ? a->out + O_POOLP + (size_t)(l * 8 + b) * 15 * 256 : nullptr, tid); }
    for (int it = bx; it < 128; it += G)
        pool_item(lds, Z, Y, pw, psc, true, MP + it * 4, 0, a->in[4] + (size_t)(l * 128 + it) * 15 * 256, a->out + O_POOLS + (size_t)(l * 128 + it) * 15 * 256, tid);
    }
    { const int gt = bx * 512 + tid, NT = G * 512; float* okp = a->out + O_KP + (size_t)l * 8 * 128 * 128; float* ovp = a->out + O_VP + (size_t)l * 8 * 128 * 128;
      for (int i = gt; i < 8 * 128 * 128; i += NT) { const int c = i & 127, j = (i >> 7) & 127, b = i >> 14; const bf16_t* zr = Z + (size_t)(b * TP + 1920 + j) * INW + c;
          okp[i] = bf2f(zr[OFF_AK]); ovp[i] = bf2f(zr[OFF_AV]); } }
    const int wave = tid >> 6, lane = tid & 63, gw = bx * 8 + wave, NGW = G * 8;
    LAS float* wl = (LAS float*)(lds + wave * 16384);
    const float* LBS = (const float*)(a->ws + WS_LBS) + l * 256; float* HU = (float*)(a->ws + WS_HU); float* HP = (float*)(a->ws + WS_HP);
for (int rp_ = 0; rp_ < (MIXPROBE == 4 ? 2 : 1); ++rp_) {
        for (int it = gw; it < 32 * HNC; it += NGW) { const int sq = it / HNC, c = it % HNC, b = sq >> 2, h = sq & 3;
        f32x2 S[32]; float P = 1.0f;
#pragma unroll
        for (int k = 0; k < 32; ++k) S[k] = (f32x2){0.f, 0.f};
        hgrn_run<false, HL>(wl, Z, Y, b * TP + c * HL, h, LBS[h * 64 + lane], 0.f, S, P, lane);
        float* up = HU + (size_t)it * 4096 + lane;
#pragma unroll
        for (int k = 0; k < 64; ++k) up[k * 64] = S[k >> 1][k & 1];
        HP[(size_t)it * 64 + lane] = P; }
    }
    const float hgn = a->in[21][l * 64 + lane];
for (int rp_ = 0; rp_ < (MIXPROBE == 5 ? 2 : 1); ++rp_) {
        for (int it = gw; it < 512; it += NGW) { const int b = it >> 2, h = it & 3;
        const float* s0 = a->in[5] + (size_t)((l * 128 + b) * 4 + h) * 4096 + lane; f32x2 S[32]; float P = 1.0f;
#pragma unroll
        for (int k = 0; k < 64; ++k) S[k >> 1][k & 1] = s0[k * 64];
        hgrn_run<true, 4>(wl, Z, Y, MP + b * 4, h, LBS[h * 64 + lane], hgn, S, P, lane);
        float* so = a->out + O_HGS + (size_t)((l * 128 + b) * 4 + h) * 4096 + lane;
#pragma unroll
        for (int k = 0; k < 64; ++k) so[k * 64] = S[k >> 1][k & 1]; }
    }
}
__device__ __forceinline__ void phase_mix2(ArgsP a, int tid, int G, int bx) {
    float* HU = (float*)(a->ws + WS_HU); const float* HP = (const float*)(a->ws + WS_HP);
    for (int e = bx * 512 + tid; e < 32 * 4096; e += G * 512) { const int sq = e >> 12, idx = e & 4095, k = idx >> 6;
        float* up = HU + (size_t)sq * HNC * 4096 + idx; const float* pp = HP + (size_t)sq * HNC * 64 + k; float S = 0.f;
        for (int c0 = 0; c0 < HNC; c0 += 32) { float u[32], p[32];
#pragma unroll
            for (int i = 0; i < 32; ++i) { u[i] = up[(size_t)(c0 + i) * 4096]; p[i] = pp[(c0 + i) * 64]; }
#pragma unroll
            for (int i = 0; i < 32; ++i) { up[(size_t)(c0 + i) * 4096] = S; S = __builtin_fmaf(p[i], S, u[i]); } } }
}
__device__ __forceinline__ void phase_mix3(ArgsP a, LAS unsigned char* lds, int l, int tid, int G, int bx) {
    const bf16_t* Z = (const bf16_t*)(a->ws + WS_Z); bf16_t* Y = (bf16_t*)(a->ws + WS_Y);
    const int wave = tid >> 6, lane = tid & 63, gw = bx * 8 + wave, NGW = G * 8;
    LAS float* wl = (LAS float*)(lds + wave * 16384);
    const float* LBS = (const float*)(a->ws + WS_LBS) + l * 256; const float* HU = (const float*)(a->ws + WS_HU);
    const float hgn = a->in[21][l * 64 + lane];
    for (int it = gw; it < 32 * HNC; it += NGW) { const int sq = it / HNC, c = it % HNC, b = sq >> 2, h = sq & 3;
        const float* up = HU + (size_t)it * 4096 + lane; f32x2 S[32]; float P = 1.0f;
#pragma unroll
        for (int k = 0; k < 64; ++k) S[k >> 1][k & 1] = up[k * 64];
        hgrn_run<true, HL>(wl, Z, Y, b * TP + c * HL, h, LBS[h * 64 + lane], hgn, S, P, lane);
        if (c == HNC - 1) { float* so = a->out + O_HGP + (size_t)((l * 8 + b) * 4 + h) * 4096 + lane;
#pragma unroll
            for (int k = 0; k < 64; ++k) so[k * 64] = S[k >> 1][k & 1]; } }
}

struct SkResid { float* X; const float* Xin; const float* gate; int gpitch; float coef;
    __device__ __forceinline__ void operator()(int row, int col, f32x4 v) const { float* xp = X + (size_t)row * D + col; const float* gp = gate + (size_t)pg8::row_batch(row) * gpitch + col;
        f32x4 x = *(const f32x4*)(Xin + (size_t)row * D + col); x = x + (*(const f32x4*)gp * coef) * v; *(f32x4*)xp = x; } };
struct SkBf16 { bf16_t* O; int ldc;
    __device__ __forceinline__ void operator()(int row, int col, f32x4 v) const { u32x2 w; w.x = pk2(v.x, v.y); w.y = pk2(v.z, v.w); *(u32x2*)(O + (size_t)row * ldc + col) = w; } };
template <int SKB, class F>
__device__ __forceinline__ void skinny_gemm(LAS unsigned char* lds, const bf16_t* A, const bf16_t* Bt, int N, int K, int row_off, int tid, int bx, int G, const F& epi) {
    const int w = tid >> 6, lane = tid & 63, fr = lane & 15, fq = lane >> 4;
    const int ntn = N >> 6, ntiles = 16 * ntn, ksl = K >> 3, nks = ksl >> 5;
    LAS float* red = (LAS float*)lds;
    for (int tile = bx; tile < ntiles; tile += G) {
        const int tm = tile / ntn, tn = tile % ntn;
        f32x4 acc[2][4];
#pragma unroll
        for (int mi = 0; mi < 2; ++mi)
#pragma unroll
            for (int ni = 0; ni < 4; ++ni) acc[mi][ni] = (f32x4){0.f, 0.f, 0.f, 0.f};
        const bf16_t* ap = A + (size_t)(tm * 32 + fr) * K + w * ksl + fq * 8;
        const bf16_t* bp = Bt + (size_t)(tn * 64 + fr) * K + w * ksl + fq * 8;
        for (int s0 = 0; s0 < nks; s0 += SKB) {
            bf16x8 af[SKB][2], bfr[SKB][4];
#pragma unroll
            for (int s = 0; s < SKB; ++s) { const int ss = min(s0 + s, nks - 1);
#pragma unroll
                for (int mi = 0; mi < 2; ++mi) af[s][mi] = *(const bf16x8*)(ap + (size_t)mi * 16 * K + ss * 32);
#pragma unroll
                for (int ni = 0; ni < 4; ++ni) bfr[s][ni] = *(const bf16x8*)(bp + (size_t)ni * 16 * K + ss * 32); }
#pragma unroll
            for (int s = 0; s < SKB; ++s) if (s0 + s < nks) {
#pragma unroll
                for (int mi = 0; mi < 2; ++mi)
#pragma unroll
                    for (int ni = 0; ni < 4; ++ni) acc[mi][ni] = __builtin_amdgcn_mfma_f32_16x16x32_bf16(af[s][mi], bfr[s][ni], acc[mi][ni], 0, 0, 0); }
        }
#pragma unroll
        for (int mi = 0; mi < 2; ++mi)
#pragma unroll
            for (int ni = 0; ni < 4; ++ni)
#pragma unroll
                for (int r = 0; r < 4; ++r) red[(w * 32 + mi * 16 + fq * 4 + r) * 64 + ni * 16 + fr] = acc[mi][ni][r];
        __syncthreads();
        { const int row = tid >> 4, c4 = (tid & 15) * 4; f32x4 sum = {0.f, 0.f, 0.f, 0.f};
#pragma unroll
          for (int ww = 0; ww < 8; ++ww) sum = sum + *(const LAS f32x4*)(red + (ww * 32 + row) * 64 + c4);
          epi(row_off + tm * 32 + row, tn * 64 + c4, sum); }
        __syncthreads();
    }
}

constexpr int NPH = 2 + 12 * DEPTH + 1;
__global__ void __launch_bounds__(512, 2) fwd_kernel(Args a_) {
    extern __shared__ __attribute__((aligned(16))) unsigned char lds_raw[];
    LAS unsigned char* lds = (LAS unsigned char*)lds_raw;
    cg::grid_group grid = cg::this_grid();
    const int ph_lo = a_.ph_lo, ph_hi = a_.ph_hi;
    volatile LAS unsigned* MISC = (volatile LAS unsigned*)(lds + 131072 + 320);
    if (threadIdx.x < 2) MISC[threadIdx.x] = 0u;
    __syncthreads();
    XcdBarrier bar; bar.bar = (unsigned*)a_.ws; bar.x = 0; bar.st = MISC;
    for (int ph = ph_lo; ph < ph_hi; ++ph) {
        if (ph == ph_lo + 1) { grid.sync(); bar = xcd_barrier_post((unsigned*)a_.ws, MISC); }
        else if (ph > ph_lo + 1) xcd_barrier(bar);
        ArgsP a = (ArgsP)__builtin_amdgcn_kernarg_segment_ptr(); asm volatile("" : "+s"(a));
        int tid = threadIdx.x; asm volatile("" : "+v"(tid));
        int bx = blockIdx.x, G = gridDim.x; asm volatile("" : "+s"(bx), "+s"(G));
        bf16_t* Hb = (bf16_t*)(a->ws + WS_H); bf16_t* Gb = (bf16_t*)(a->ws + WS_G); bf16_t* Zb = (bf16_t*)(a->ws + WS_Z); bf16_t* Yb = (bf16_t*)(a->ws + WS_Y);
        float* MOD = (float*)(a->ws + WS_MOD);
        if (ph == 0) { phase_prologue(a, lds, tid, G, bx); continue; }
        if (ph == 1) { pg8::Gemm g{(const bf16_t*)(a->ws + WS_SC), (const bf16_t*)(a->ws + WS_WMOD), 256, NMOD, D}; pg8::StaticOrder S; S.init(256, NMOD, G, bx);
            pg8::EpiF32Bias E{MOD, NMOD, a->in[12]}; pg8::gemm_phase<pg8::EpiF32Bias, pg8::StaticOrder, true, true>(lds, g, S, E); continue; }
        if (ph == NPH - 1) { phase_norm<true>(a, a->in[27], 0, false, tid, G, bx); continue; }
        const int l = (ph - 2) / 12, s = (ph - 2) % 12;
        unsigned char* wl = a->ws + WS_WL + (size_t)l * WL_STRIDE;
        if (s == 0 || s == 3 || s == 9) { const int sub = s == 0 ? 0 : (s == 3 ? 1 : 2); const float* nw = s == 0 ? a->in[8] : (s == 3 ? a->in[9] : a->in[10]); phase_norm<false>(a, nw + l * D, l * NMODL + 3 * sub * D, ph == 2, tid, G, bx); }
        else if (s == 1 || s == 10) { pg8::Gemm g{Hb, (const bf16_t*)(wl + (s == 1 ? WL_GU1 : WL_GU2)), MT, 2 * FF, D}; pg8::StaticOrder S; S.init(MT, 2 * FF, G, bx);
            pg8::EpiSwiGLU E{Gb, FF}; pg8::gemm_phase<pg8::EpiSwiGLU, pg8::StaticOrder, true, true>(lds, g, S, E);
            if (l < DEPTH - 1) { __syncthreads(); deferred_transposes(a, lds, l + 1, s == 1 ? 0 : 1, ((MT / 256) * (2 * FF / 256)) % G, tid, G, bx); } }
        else if (s == 2 || s == 11 || s == 8) {
            const int Kd = s == 8 ? D : FF; const bf16_t* Ad = s == 8 ? Yb : Gb; const bf16_t* Bd = (const bf16_t*)(wl + (s == 2 ? WL_D1 : (s == 11 ? WL_D2 : WL_WOUT)));
            pg8::Gemm g{Ad, Bd, MP, D, Kd}; pg8::StaticOrder S; S.init(MP, D, G, bx);
            const bool first = (l == 0 && s == 2);
            pg8::EpiResid E{a->out, first ? a->in[0] : a->out, MOD + l * NMODL + (s == 2 ? 2 : (s == 8 ? 5 : 8)) * D, NMOD, s == 8 ? 1.0f : 0.5f}; pg8::gemm_phase<pg8::EpiResid, pg8::StaticOrder, false, true>(lds, g, S, E);
            __syncthreads();
            SkResid SE{a->out, first ? a->in[1] - (size_t)MP * D : a->out, E.gate, NMOD, E.coef}; if (s == 8) skinny_gemm<4>(lds, Ad + (size_t)MP * Kd, Bd, D, Kd, MP, tid, bx, G, SE); else skinny_gemm<6>(lds, Ad + (size_t)MP * Kd, Bd, D, Kd, MP, tid, bx, G, SE); }
        else if (s == 4) { pg8::Gemm g{Hb, (const bf16_t*)(wl + WL_WIN), MP, INW, D}; pg8::StaticOrder S; S.init(MP, INW, G, bx);
            pg8::EpiBf16<0> E{Zb, INW, nullptr, 0, 0, 1.f}; pg8::gemm_phase<pg8::EpiBf16<0>, pg8::StaticOrder, true, true>(lds, g, S, E);
            __syncthreads();
            SkBf16 SE{Zb, INW}; skinny_gemm<4>(lds, Hb + (size_t)MP * D, (const bf16_t*)(wl + WL_WIN), INW, D, MP, tid, bx, G, SE); }
        else if (s == 5) phase_mix1(a, lds, l, tid, G, bx);
        else if (s == 6) phase_mix2(a, tid, G, bx);
        else phase_mix3(a, lds, l, tid, G, bx);
    }
}

extern "C" void kernel_launch(void* const* d_in, const int* in_sizes, int n_in, void* d_out, int out_size, void* d_ws, size_t ws_size, hipStream_t stream) {
    static int grid = 0;
    if (grid == 0) {
        if (n_in != 28 || (size_t)out_size != O_END || ws_size < WS_END) { fprintf(stderr, "kernel_launch: unexpected shapes (n_in %d, out %d, ws %zu); nothing launched\n", n_in, out_size, ws_size); grid = -1; return; }
        int dev = 0, cus = 0, per_cu = 0;
        if (hipGetDevice(&dev) != hipSuccess || hipDeviceGetAttribute(&cus, hipDeviceAttributeMultiprocessorCount, dev) != hipSuccess) { grid = -1; return; }
        if (hipFuncSetAttribute((const void*)fwd_kernel, hipFuncAttributeMaxDynamicSharedMemorySize, LDS_BYTES) != hipSuccess) { fprintf(stderr, "kernel_launch: hipFuncSetAttribute failed\n"); grid = -1; return; }
        if (hipOccupancyMaxActiveBlocksPerMultiprocessor(&per_cu, (const void*)fwd_kernel, 512, LDS_BYTES) != hipSuccess || per_cu < 1) fprintf(stderr, "kernel_launch: occupancy query says %d blocks per CU\n", per_cu);
        (void)hipGetLastError();
        grid = cus;
    }
    if (grid < 0) return;
    Args a{};
    for (int i = 0; i < 28; ++i) a.in[i] = (const float*)d_in[i];
    a.out = (float*)d_out; a.ws = (unsigned char*)d_ws;
#if MK_MULTI
    for (int ph = 0; ph < NPH; ++ph) { a.ph_lo = ph; a.ph_hi = ph + 1; hipLaunchKernelGGL(fwd_kernel, dim3(grid), dim3(512), LDS_BYTES, stream, a); }
#else
    a.ph_lo = 0; a.ph_hi = NPH;
    void* kargs[] = {&a};
    const hipError_t e = hipLaunchCooperativeKernel((const void*)fwd_kernel, dim3(grid), dim3(512), kargs, LDS_BYTES, stream);
    if (e != hipSuccess) fprintf(stderr, "kernel_launch: cooperative launch failed: %s (grid %d)\n", hipGetErrorString(e), grid);
#endif
}
```

```cpp
#include <hip/hip_runtime.h>
#include <hip/hip_cooperative_groups.h>
#include <cstdio>
#include <cstdint>
namespace cg = cooperative_groups;
namespace pg8 {
#define PG8_LAS __attribute__((address_space(3)))
typedef unsigned short bf16_t;
typedef short bf16x8 __attribute__((ext_vector_type(8)));
typedef float f32x4 __attribute__((ext_vector_type(4)));
typedef unsigned u32x4 __attribute__((ext_vector_type(4)));
constexpr int BM = 256, BK = 64, HALF = 128, HTB = HALF * BK * 2  , STAGE_BYTES = 8 * HTB, NXCD = 8, WGM = 8;

__host__ __device__ __forceinline__ int lds_byte(int r, int c) { const int st = (r >> 4) * 2 + (c >> 5), rr = r & 15, cc = c & 31, ob = rr * 64 + cc * 2; return st * 1024 + (ob ^ (((ob >> 9) & 1) << 5)); }
__host__ __device__ __forceinline__ void stage_rc(int b, int& R, int& C) { const int st = b / 1024, sb = b % 1024, swz = sb ^ (((sb >> 9) & 1) << 5); R = (st >> 1) * 16 + swz / 64; C = (st & 1) * 32 + (swz % 64) / 2; }
__host__ __device__ __forceinline__ int perm32(int rho) { const int n = rho >> 4, i = rho & 15; return 8 * (i >> 2) + 4 * n + (i & 3); }

struct Unit { int pm, pn; };
struct Gemm { const bf16_t* A; const bf16_t* Bt; int M, N, K; };

struct StaticOrder {
    int nM, nN, nwg, G, c;
    __host__ __device__ void init(int M, int N, int G_, int c_) { nM = M / BM; nN = N / BM; nwg = nM * nN; G = G_; c = c_; }
    __host__ __device__ bool next(int i, Unit& u) const {
        const long L = (long)i * G + c; if (L >= nwg) return false;
        int wgid = (int)L; { const int q = nwg / NXCD, r = nwg % NXCD, xcd = wgid % NXCD, off = wgid / NXCD; wgid = (xcd < r ? xcd * (q + 1) : r * (q + 1) + (xcd - r) * q) + off; }
        const int nig = WGM * nN, gid = wgid / nig, fm = gid * WGM, gsz = (nM - fm) < WGM ? (nM - fm) : WGM;
        u.pm = fm + ((wgid % nig) % gsz); u.pn = (wgid % nig) / gsz; return true;
    }
    __device__ __forceinline__ void a_ready(const Unit&) const {}
    __device__ __forceinline__ void done(const Unit&) const {}
};

__device__ __forceinline__ unsigned cvt_pk_bf16(float lo, float hi) { unsigned r; asm volatile("v_cvt_pk_bf16_f32 %0, %1, %2" : "=v"(r) : "v"(lo), "v"(hi)); return r; }
typedef float f32x2 __attribute__((ext_vector_type(2)));
__device__ __forceinline__ f32x2 gelu_pk(f32x2 v) {
    const f32x2 av = __builtin_elementwise_abs(v), d = av * 0.2316418882f + 1.0f;
    f32x2 t; t.x = __builtin_amdgcn_rcpf(d.x); t.y = __builtin_amdgcn_rcpf(d.y);
    f32x2 q = t * 0.5307027145f + (-0.7265760135f); q = q * t + 0.7107068705f; q = q * t + (-0.142248368f); q = q * t + 0.127414796f; q = q * t;
    const f32x2 s = (v * v) * (-0.72134752044f);
    f32x2 e; e.x = __builtin_amdgcn_exp2f(s.x); e.y = __builtin_amdgcn_exp2f(s.y);
    const f32x2 m = v * (q * e), r = v - m;
    f32x2 o; o.x = v.x < 0.f ? m.x : r.x; o.y = v.y < 0.f ? m.y : r.y; return o;
}

template <int ACT  > struct EpiBf16 {
    static constexpr bool PERM = true, AFTER_DRAIN = false; static_assert(ACT == 0 || ACT == 1, "EpiBf16: ACT is 0 (none) or 1 (gelu_pk)");
    bf16_t* O; int ldc; const float* bias; int split_cols; size_t split_stride; float scale0;
    __device__ __forceinline__ void operator()(const f32x4 (&acc)[2][2][4][2], const Unit& u, int wr, int wc, int fr, int fq) const {
        const int row0 = u.pm * BM + wr * 64 + fr; int colt = u.pn * BM; bf16_t* base = O;
        float sc = 1.f; if (split_cols) { const int t = colt / split_cols; base += (size_t)t * split_stride; colt -= t * split_cols; if (t == 0) sc = scale0; }
        const int col0 = colt + wc * 32 + 8 * fq, bcol0 = u.pn * BM + wc * 32 + 8 * fq;
        f32x4 bv[2][2];
#pragma unroll
        for (int bj = 0; bj < 2; ++bj)
#pragma unroll
            for (int n = 0; n < 2; ++n) bv[bj][n] = bias ? *(const f32x4*)(bias + bcol0 + bj * HALF + 4 * n) : (f32x4){0.f, 0.f, 0.f, 0.f};
#pragma unroll
        for (int ai = 0; ai < 2; ++ai)
#pragma unroll
            for (int m = 0; m < 4; ++m) { bf16_t* rowp = base + (size_t)(row0 + ai * HALF + m * 16) * ldc + col0;
#pragma unroll
                for (int bj = 0; bj < 2; ++bj) { f32x4 v0 = acc[ai][bj][m][0] + bv[bj][0], v1 = acc[ai][bj][m][1] + bv[bj][1];
                    if (ACT == 1) { f32x2 a = gelu_pk((f32x2){v0[0], v0[1]}), b = gelu_pk((f32x2){v0[2], v0[3]}), c = gelu_pk((f32x2){v1[0], v1[1]}), d = gelu_pk((f32x2){v1[2], v1[3]});
                        v0 = (f32x4){a.x, a.y, b.x, b.y}; v1 = (f32x4){c.x, c.y, d.x, d.y}; }
                    v0 = v0 * sc; v1 = v1 * sc; u32x4 w; w.x = cvt_pk_bf16(v0[0], v0[1]); w.y = cvt_pk_bf16(v0[2], v0[3]); w.z = cvt_pk_bf16(v1[0], v1[1]); w.w = cvt_pk_bf16(v1[2], v1[3]);
                    *(u32x4*)(rowp + bj * HALF) = w; } }
    }
};
__device__ __forceinline__ float silu_fast(float x) { return x * __builtin_amdgcn_rcpf(1.0f + __expf(-x)); }
__device__ __forceinline__ int row_batch(int row) { return row < 16384 ? (row >> 11) : 8 + ((row - 16384) >> 2); }
struct EpiSwiGLU {
    static constexpr bool PERM = true, AFTER_DRAIN = false;
    bf16_t* O; int ldc;
    __device__ __forceinline__ void operator()(const f32x4 (&acc)[2][2][4][2], const Unit& u, int wr, int wc, int fr, int fq) const {
        const int row0 = u.pm * BM + wr * 64 + fr; const int col0 = u.pn * HALF + wc * 32 + 8 * fq;
#pragma unroll
        for (int ai = 0; ai < 2; ++ai)
#pragma unroll
            for (int m = 0; m < 4; ++m) { bf16_t* rowp = O + (size_t)(row0 + ai * HALF + m * 16) * ldc + col0;
                const f32x4 g0 = acc[ai][0][m][0], g1 = acc[ai][0][m][1], u0 = acc[ai][1][m][0], u1 = acc[ai][1][m][1];
                u32x4 w; w.x = cvt_pk_bf16(silu_fast(g0[0]) * u0[0], silu_fast(g0[1]) * u0[1]); w.y = cvt_pk_bf16(silu_fast(g0[2]) * u0[2], silu_fast(g0[3]) * u0[3]);
                w.z = cvt_pk_bf16(silu_fast(g1[0]) * u1[0], silu_fast(g1[1]) * u1[1]); w.w = cvt_pk_bf16(silu_fast(g1[2]) * u1[2], silu_fast(g1[3]) * u1[3]);
                *(u32x4*)rowp = w; }
    }
};
struct EpiResid {
    static constexpr bool PERM = false, AFTER_DRAIN = false;
    float* X; const float* Xin; const float* gate; int gpitch; float coef;
    __device__ __forceinline__ void operator()(const f32x4 (&acc)[2][2][4][2], const Unit& u, int wr, int wc, int fr, int fq) const {
        const int col0 = u.pn * BM + wc * 32 + 4 * fq; const float* gp = gate + (size_t)row_batch(u.pm * BM) * gpitch + col0;
        f32x4 gv[2][2];
#pragma unroll
        for (int bj = 0; bj < 2; ++bj)
#pragma unroll
            for (int n = 0; n < 2; ++n) gv[bj][n] = *(const f32x4*)(gp + bj * HALF + n * 16) * coef;
#pragma unroll
        for (int ai = 0; ai < 2; ++ai) { const size_t r0 = (size_t)(u.pm * BM + ai * HALF + wr * 64 + fr) * 1024 + col0; f32x4 xv[4][2][2];
#pragma unroll
            for (int m = 0; m < 4; ++m)
#pragma unroll
                for (int bj = 0; bj < 2; ++bj)
#pragma unroll
                    for (int n = 0; n < 2; ++n) xv[m][bj][n] = *(const f32x4*)(Xin + r0 + (size_t)m * 16 * 1024 + bj * HALF + n * 16);
#pragma unroll
            for (int m = 0; m < 4; ++m)
#pragma unroll
                for (int bj = 0; bj < 2; ++bj)
#pragma unroll
                    for (int n = 0; n < 2; ++n) *(f32x4*)(X + r0 + (size_t)m * 16 * 1024 + bj * HALF + n * 16) = xv[m][bj][n] + gv[bj][n] * acc[ai][bj][m][n]; }
    }
};
struct EpiF32Bias {
    static constexpr bool PERM = false, AFTER_DRAIN = false;
    float* O; int ldc; const float* bias; int nrows;
    __device__ __forceinline__ void operator()(const f32x4 (&acc)[2][2][4][2], const Unit& u, int wr, int wc, int fr, int fq) const {
        const int col0 = u.pn * BM + wc * 32 + 4 * fq;
#pragma unroll
        for (int ai = 0; ai < 2; ++ai)
#pragma unroll
            for (int m = 0; m < 4; ++m) { const int row = u.pm * BM + ai * HALF + wr * 64 + m * 16 + fr; float* op = O + (size_t)row * ldc + col0;
#pragma unroll
                for (int bj = 0; bj < 2; ++bj)
#pragma unroll
                    for (int n = 0; n < 2; ++n) { const f32x4 b4 = *(const f32x4*)(bias + col0 + bj * HALF + n * 16); if (row < nrows) *(f32x4*)(op + bj * HALF + n * 16) = acc[ai][bj][m][n] + b4; } }
    }
};
template <class Epi, class Sched, bool ALIGN_EPI = false, bool SP2 = false>
__device__ __forceinline__ void gemm_phase(PG8_LAS unsigned char* lds, const Gemm g, const Sched& S, const Epi& E) {
    int tid_ = threadIdx.x; asm volatile("" : "+v"(tid_)); const int tid = tid_, wid = __builtin_amdgcn_readfirstlane(tid >> 6), lane = tid & 63, wr = wid >> 2, wc = wid & 3, fr = lane & 15, fq = lane >> 4;
    const int K = g.K, nt = K / BK;
    unsigned voffA[2], voffB[2];
#pragma unroll
    for (int i = 0; i < 2; ++i) { int R, C; stage_rc(tid * 16 + i * 8192, R, C); const int Rb = Epi::PERM ? ((R & ~31) + perm32(R & 31)) : R;
        voffA[i] = (unsigned)(R * K + C) * 2u; voffB[i] = (unsigned)(Rb * K + C) * 2u; }
    const size_t kstep = (size_t)(BK * 2);
    const size_t hstep = (size_t)HALF * K * 2;
    const size_t tstep = 2 * hstep;
    const unsigned ldsw = (unsigned)wid * 1024u;
    const int aoff = lds_byte(wr * 64 + fr, fq * 8), boff = lds_byte(wc * 32 + fr, fq * 8);
#define PG8_SA(b, h) (((b) * 2 + (h)) * HTB)
#define PG8_SB(b, h) ((4 + (b) * 2 + (h)) * HTB)
#define PG8_STAGE(bufoff, gbase, voff) do { _Pragma("unroll") for (int _i = 0; _i < 2; ++_i) \
        __builtin_amdgcn_global_load_lds((const unsigned*)((const char*)(gbase) + (voff)[_i]), (PG8_LAS unsigned*)(lds + (bufoff) + ldsw + _i * 8192), 16, 0, 0); } while (0)
#define PG8_LDA(dst, b, h) do { _Pragma("unroll") for (int m = 0; m < 4; ++m) _Pragma("unroll") for (int k = 0; k < 2; ++k) dst[m][k] = *(const PG8_LAS bf16x8*)(lds + PG8_SA(b, h) + aoff + m * 2048 + k * 1024); } while (0)
#define PG8_LDB(dst, b, h) do { _Pragma("unroll") for (int n = 0; n < 2; ++n) _Pragma("unroll") for (int k = 0; k < 2; ++k) dst[n][k] = *(const PG8_LAS bf16x8*)(lds + PG8_SB(b, h) + boff + n * 2048 + k * 1024); } while (0)
#define PG8_MMA(ai, bj, At, Bt) do { __builtin_amdgcn_s_setprio(1); _Pragma("unroll") for (int m = 0; m < 4; ++m) _Pragma("unroll") for (int n = 0; n < 2; ++n) _Pragma("unroll") for (int k = 0; k < 2; ++k) \
        acc[ai][bj][m][n] = __builtin_amdgcn_mfma_f32_16x16x32_bf16(Bt[n][k], At[m][k], acc[ai][bj][m][n], 0, 0, 0); __builtin_amdgcn_s_setprio(0); } while (0)
#define PG8_WAIT_V(n) asm volatile("s_waitcnt vmcnt(" #n ")" ::: "memory")
#define PG8_WAIT_L(n) asm volatile("s_waitcnt lgkmcnt(" #n ")" ::: "memory")
#define PG8_BAR __builtin_amdgcn_s_barrier()
#define PG8_SCHED __builtin_amdgcn_sched_barrier(0)
    Unit cur, nxt; int ui = 0;
    if (!S.next(0, cur)) return;
    f32x4 acc[2][2][4][2];
#pragma unroll
    for (int a = 0; a < 2; ++a)
#pragma unroll
        for (int b = 0; b < 2; ++b)
#pragma unroll
            for (int m = 0; m < 4; ++m)
#pragma unroll
                for (int n = 0; n < 2; ++n) acc[a][b][m][n] = (f32x4){0.f, 0.f, 0.f, 0.f};
    bf16x8 At[4][2], B0[2][2], B1[2][2];
    const char* cA = (const char*)g.A + (size_t)cur.pm * tstep; const char* cB = (const char*)g.Bt + (size_t)cur.pn * tstep;
    S.a_ready(cur);
    if constexpr (SP2) {
        PG8_STAGE(PG8_SB(0, 0), cB, voffB); PG8_STAGE(PG8_SB(0, 1), cB + hstep, voffB); PG8_STAGE(PG8_SA(0, 0), cA, voffA); PG8_STAGE(PG8_SA(0, 1), cA + hstep, voffA);
        if (wr == 1) PG8_BAR;
        PG8_WAIT_V(2); PG8_BAR;
        PG8_STAGE(PG8_SB(1, 0), cB + kstep, voffB); PG8_STAGE(PG8_SA(1, 0), cA + kstep, voffA); PG8_STAGE(PG8_SB(1, 1), cB + hstep + kstep, voffB);
        PG8_WAIT_V(6); PG8_BAR;
    } else {
        PG8_STAGE(PG8_SB(0, 0), cB, voffB); PG8_STAGE(PG8_SA(0, 0), cA, voffA); PG8_STAGE(PG8_SB(0, 1), cB + hstep, voffB); PG8_STAGE(PG8_SA(0, 1), cA + hstep, voffA);
        if (wr == 1) PG8_BAR;
        PG8_WAIT_V(4); PG8_BAR;
        PG8_STAGE(PG8_SB(1, 0), cB + kstep, voffB); PG8_STAGE(PG8_SA(1, 0), cA + kstep, voffA); PG8_STAGE(PG8_SB(1, 1), cB + hstep + kstep, voffB);
        PG8_WAIT_V(6); PG8_BAR;
    }
    for (;;) {
        const bool has_next = S.next(ui + 1, nxt);
        const char* nA = has_next ? (const char*)g.A + (size_t)nxt.pm * tstep : cA; const char* nB = has_next ? (const char*)g.Bt + (size_t)nxt.pn * tstep : cB;
        for (int t = 0; t < nt; t += 2) {
            const bool last = (t == nt - 2);
            const char* a1 = cA + (size_t)(t + 1) * kstep;
            const char* a2 = last ? nA : cA + (size_t)(t + 2) * kstep; const char* b2 = last ? nB : cB + (size_t)(t + 2) * kstep;
            const char* a3 = a2 + kstep; const char* b3 = b2 + kstep;
            if (last && has_next) S.a_ready(nxt);
            if constexpr (SP2) {
            PG8_LDB(B0, 0, 0); PG8_LDB(B1, 0, 1); PG8_SCHED; PG8_LDA(At, 0, 0); PG8_STAGE(PG8_SA(1, 1), a1 + hstep, voffA);
            PG8_WAIT_V(8); PG8_WAIT_L(0); PG8_BAR; PG8_MMA(0, 0, At, B0); PG8_MMA(0, 1, At, B1); PG8_BAR; PG8_SCHED;
            PG8_LDA(At, 0, 1); PG8_STAGE(PG8_SB(0, 0), b2, voffB); PG8_STAGE(PG8_SB(0, 1), b2 + hstep, voffB); PG8_STAGE(PG8_SA(0, 0), a2, voffA);
            PG8_WAIT_V(8); PG8_WAIT_L(0); PG8_BAR; PG8_MMA(1, 0, At, B0); PG8_MMA(1, 1, At, B1); PG8_BAR; PG8_SCHED;
            PG8_LDB(B0, 1, 0); PG8_LDB(B1, 1, 1); PG8_SCHED; PG8_LDA(At, 1, 0); PG8_STAGE(PG8_SA(0, 1), a2 + hstep, voffA);
            PG8_WAIT_V(8); PG8_WAIT_L(0); PG8_BAR; PG8_MMA(0, 0, At, B0); PG8_MMA(0, 1, At, B1); PG8_BAR; PG8_SCHED;
            PG8_LDA(At, 1, 1); PG8_STAGE(PG8_SB(1, 0), b3, voffB); PG8_STAGE(PG8_SB(1, 1), b3 + hstep, voffB); PG8_STAGE(PG8_SA(1, 0), a3, voffA);
            PG8_WAIT_V(8); PG8_WAIT_L(0); PG8_BAR; PG8_MMA(1, 0, At, B0); PG8_MMA(1, 1, At, B1); PG8_BAR; PG8_SCHED;
            } else {
            PG8_LDB(B0, 0, 0); PG8_SCHED; PG8_LDA(At, 0, 0); PG8_STAGE(PG8_SA(1, 1), a1 + hstep, voffA);
            PG8_WAIT_L(8); PG8_BAR; PG8_WAIT_L(0); PG8_MMA(0, 0, At, B0); PG8_BAR; PG8_SCHED;
            PG8_LDB(B1, 0, 1); PG8_STAGE(PG8_SB(0, 0), b2, voffB);
            PG8_BAR; PG8_WAIT_L(0); PG8_MMA(0, 1, At, B1); PG8_BAR;
            PG8_LDA(At, 0, 1); PG8_STAGE(PG8_SA(0, 0), a2, voffA);
            PG8_BAR; PG8_WAIT_L(0); PG8_MMA(1, 0, At, B0); PG8_BAR; PG8_SCHED;
            PG8_STAGE(PG8_SB(0, 1), b2 + hstep, voffB);
            PG8_WAIT_V(6); PG8_BAR; PG8_MMA(1, 1, At, B1); PG8_BAR;
            PG8_LDB(B0, 1, 0); PG8_SCHED; PG8_LDA(At, 1, 0); PG8_STAGE(PG8_SA(0, 1), a2 + hstep, voffA);
            PG8_WAIT_L(8); PG8_BAR; PG8_WAIT_L(0); PG8_MMA(0, 0, At, B0); PG8_BAR; PG8_SCHED;
            PG8_LDB(B1, 1, 1); PG8_STAGE(PG8_SB(1, 0), b3, voffB);
            PG8_BAR; PG8_WAIT_L(0); PG8_MMA(0, 1, At, B1); PG8_BAR;
            PG8_LDA(At, 1, 1); PG8_STAGE(PG8_SA(1, 0), a3, voffA);
            PG8_BAR; PG8_WAIT_L(0); PG8_MMA(1, 0, At, B0); PG8_BAR; PG8_SCHED;
            PG8_STAGE(PG8_SB(1, 1), b3 + hstep, voffB);
            PG8_WAIT_V(6); PG8_BAR; PG8_MMA(1, 1, At, B1); PG8_BAR;
            }
        }
        if constexpr (ALIGN_EPI) { if (wr == 0) PG8_BAR; }
        if constexpr (!Epi::AFTER_DRAIN) { E(acc, cur, wr, wc, fr, fq); S.done(cur); }
        if (!has_next) break;
#pragma unroll
        for (int a = 0; a < 2; ++a)
#pragma unroll
            for (int b = 0; b < 2; ++b)
#pragma unroll
                for (int m = 0; m < 4; ++m)
#pragma unroll
                    for (int n = 0; n < 2; ++n) acc[a][b][m][n] = (f32x4){0.f, 0.f, 0.f, 0.f};
        cur = nxt; cA = nA; cB = nB; ++ui;
        if constexpr (ALIGN_EPI) { if (wr == 1) PG8_BAR; }
    }
    PG8_WAIT_V(0);
    if constexpr (!ALIGN_EPI) { if (wr == 0) PG8_BAR; }
    PG8_BAR;
    if constexpr (Epi::AFTER_DRAIN) { E.fused(acc, cur, wr, wc, fr, fq, lds, wid, lane); S.done(cur); }
#undef PG8_SA
#undef PG8_SB
#undef PG8_STAGE
#undef PG8_LDA
#undef PG8_LDB
#undef PG8_MMA
#undef PG8_WAIT_V
#undef PG8_WAIT_L
#undef PG8_BAR
#undef PG8_SCHED
}
}
#ifndef MIXPROBE
#define MIXPROBE 0
#endif
#ifndef MK_MULTI
#define MK_MULTI 0
#endif
#define LAS __attribute__((address_space(3)))
typedef unsigned short bf16_t;
typedef short bf16x8 __attribute__((ext_vector_type(8)));
typedef float f32x4 __attribute__((ext_vector_type(4)));
typedef float f32x16 __attribute__((ext_vector_type(16)));
typedef unsigned u32x4 __attribute__((ext_vector_type(4)));
typedef unsigned u32x2 __attribute__((ext_vector_type(2)));
typedef float f32x2 __attribute__((ext_vector_type(2)));
#define LDS_WAIT() asm volatile("s_waitcnt lgkmcnt(0)" ::: "memory")

constexpr int D = 1024, TP = 2048, MP = 16384, MS = 512, MT = MP + MS;
constexpr int FF = 2816, INW = 2048, NMODL = 9216, NMOD = 4 * NMODL, DEPTH = 4;
constexpr int OFF_HQ = 256, OFF_HF = 512, OFF_HI = 768, OFF_HG = 1024, OFF_AQ = 1280, OFF_AK = 1792, OFF_AV = 1920;
constexpr int HL = 32, HNC = TP / HL;
constexpr float EPS = 1e-6f;
constexpr int LDS_BYTES = 147456;
constexpr size_t O_Y = 0, O_POOLP = 17301504, O_HGP = 17424384, O_KP = 17948672, O_VP = 18472960, O_POOLS = 18997248, O_HGS = 20963328, O_KS = 29351936, O_VS = 37740544, O_END = 46129152;
constexpr size_t MiB = 1u << 20;
constexpr size_t WS_LBS = 1 * MiB, WS_SC = 2 * MiB, WS_WMOD = 4 * MiB, WS_WL = 76 * MiB, WL_STRIDE = 39 * MiB;
constexpr size_t WL_GU1 = 0, WL_D1 = 11 * MiB, WL_WIN = 16 * MiB + MiB / 2, WL_WOUT = 20 * MiB + MiB / 2, WL_GU2 = 22 * MiB + MiB / 2, WL_D2 = 33 * MiB + MiB / 2;
constexpr size_t WS_MOD = 232 * MiB, WS_H = 268 * MiB, WS_G = 301 * MiB, WS_Z = 301 * MiB, WS_Y = 367 * MiB, WS_HU = 400 * MiB, WS_HP = 432 * MiB, WS_END = 434 * MiB;
static_assert(WL_D2 + (size_t)D * FF * 2 <= WL_STRIDE && WS_WL + 4 * WL_STRIDE <= WS_MOD && WS_MOD + (size_t)256 * NMOD * 4 <= WS_H && WS_H + (size_t)MT * D * 2 <= WS_G, "ws map");
static_assert(WS_G + (size_t)MT * FF * 2 <= WS_HU && WS_Z + (size_t)MT * INW * 2 <= WS_Y && WS_Y + (size_t)MT * D * 2 <= WS_HU && WS_HU + (size_t)32 * HNC * 4096 * 4 <= WS_HP, "ws map 2");

__constant__ unsigned char c_bucket[128] = {0, 1, 2, 3, 4, 5, 6, 7, 8, 9, 10, 11, 12, 13, 14, 15, 16, 16, 16, 17, 17, 18, 18, 18, 19, 19, 19, 20, 20, 20, 20, 21, 21, 21, 21, 22, 22, 22, 22, 22, 23, 23, 23, 23, 23, 23, 24, 24, 24, 24, 24, 24, 25, 25, 25, 25, 25, 25, 25, 26, 26, 26, 26, 26, 26, 26, 26, 27, 27, 27, 27, 27, 27, 27, 27, 27, 27, 28, 28, 28, 28, 28, 28, 28, 28, 28, 28, 29, 29, 29, 29, 29, 29, 29, 29, 29, 29, 29, 29, 30, 30, 30, 30, 30, 30, 30, 30, 30, 30, 30, 30, 30, 30, 31, 31, 31, 31, 31, 31, 31, 31, 31, 31, 31, 31, 31, 31, 31};

__device__ __forceinline__ unsigned pk2(float lo, float hi) { unsigned r; asm("v_cvt_pk_bf16_f32 %0, %1, %2" : "=v"(r) : "v"(lo), "v"(hi)); return r; }
__device__ __forceinline__ unsigned f2bf(float f) { return pk2(f, 0.0f) & 0xffffu; }
__device__ __forceinline__ float bf2f(unsigned u) { return __builtin_bit_cast(float, u << 16); }
__device__ __forceinline__ float silu_p(float x) { return x * __builtin_amdgcn_rcpf(1.0f + __expf(-x)); }
template <int CTRL> __device__ __forceinline__ float dpp_f(float x) { return __builtin_bit_cast(float, __builtin_amdgcn_update_dpp(0, __builtin_bit_cast(int, x), CTRL, 0xf, 0xf, true)); }
__device__ __forceinline__ float wave_sum(float v) {
    v += dpp_f<0xB1>(v); v += dpp_f<0x4E>(v); v += dpp_f<0x141>(v); v += dpp_f<0x140>(v);
    v += __shfl_xor(v, 16); v += __shfl_xor(v, 32);
    return v;
}
__device__ __forceinline__ float wave_max(float v) {
#pragma unroll
    for (int o = 1; o < 64; o <<= 1) v = fmaxf(v, __shfl_xor(v, o));
    return v;
}

struct Args { const float* in[28]; float* out; unsigned char* ws; int ph_lo, ph_hi; };
typedef const __attribute__((address_space(4))) Args* ArgsP;

#define XB_TMO      128
#define XB_XCNT(j)  (256  + 64 * (j))
#define XB_XSUB(j)  (1280 + 64 * (j))
#define XB_XGEN(j)  (2304 + 64 * (j))
#define XB_TOP      3328
#define XB_TOPGEN   3392
#define XCD_BAR_WORDS 3456
#define XB_SPIN_CAP (1u << 18)

__device__ __forceinline__ unsigned xb_ld(unsigned* p)              { return __hip_atomic_load(p, __ATOMIC_RELAXED, __HIP_MEMORY_SCOPE_AGENT); }
__device__ __forceinline__ unsigned xb_add(unsigned* p, unsigned v) { return __hip_atomic_fetch_add(p, v, __ATOMIC_RELAXED, __HIP_MEMORY_SCOPE_AGENT); }
__device__ __forceinline__ unsigned xb_xcc_id() { return (unsigned)__builtin_amdgcn_s_getreg((3 << 11) | 20) & 0xFu; }
#define XB_SPIN(cond, bar) do { unsigned _sp = 0; while (cond) { __builtin_amdgcn_s_sleep(1); \
    if ((++_sp & 255u) == 0u) { if (xb_ld(&(bar)[XB_TMO])) break; if (_sp > XB_SPIN_CAP) { atomicAdd(&(bar)[XB_TMO], 1u); break; } } } } while (0)

struct XcdBarrier {
    unsigned* bar; unsigned x;
    volatile LAS unsigned* st;
};

__device__ __forceinline__ XcdBarrier xcd_barrier_post(unsigned* bar, volatile LAS unsigned* st) {
    XcdBarrier b; b.bar = bar; b.x = xb_xcc_id(); b.st = st;
    if (threadIdx.x == 0) (void)xb_add(&bar[XB_XCNT(b.x)], 1u);
    return b;
}
__device__ __forceinline__ void xcd_barrier_complete(unsigned* bar, unsigned x, unsigned& nloc, unsigned& nx) {
    const unsigned G = gridDim.x * gridDim.y * gridDim.z;
    unsigned sum, cnt, mine, sp = 0u;
    for (;;) {
        sum = 0u; cnt = 0u; mine = 0u;
#pragma unroll
        for (unsigned j = 0; j < 16; ++j) { const unsigned c = xb_ld(&bar[XB_XCNT(j)]); sum += c; cnt += (c > 0u) ? 1u : 0u; mine = (j == x) ? c : mine; }
        if (sum == G) break;
        __builtin_amdgcn_s_sleep(1);
        if ((++sp & 255u) == 0u) { if (xb_ld(&bar[XB_TMO])) break; if (sp > XB_SPIN_CAP) { atomicAdd(&bar[XB_TMO], 1u); break; } }
    }
    nloc = mine > 0u ? mine : 1u; nx = cnt > 0u ? cnt : 1u;
}

__device__ __forceinline__ void xcd_barrier(const XcdBarrier& b) {
    asm volatile("s_waitcnt vmcnt(0)" ::: "memory");
    __syncthreads();
    if (threadIdx.x == 0) {
        unsigned* bar = b.bar;
        __builtin_amdgcn_s_waitcnt(0);
        unsigned nloc = b.st[0], nx = b.st[1];
        if (nloc == 0u) { xcd_barrier_complete(bar, b.x, nloc, nx); b.st[0] = nloc; b.st[1] = nx; }
        const unsigned old = xb_add(&bar[XB_XSUB(b.x)], 1u);
        const unsigned gen = old / nloc;
        if (old + 1u == (gen + 1u) * nloc) {
            __builtin_amdgcn_fence(__ATOMIC_RELEASE, "agent");
            asm volatile("s_waitcnt vmcnt(0)" ::: "memory");
            const unsigned og = xb_add(&bar[XB_TOP], 1u);
            const unsigned tg = og / nx;
            if (og + 1u == (tg + 1u) * nx) xb_add(&bar[XB_TOPGEN], 1u);
            else XB_SPIN(xb_ld(&bar[XB_TOPGEN]) == tg, bar);
            __builtin_amdgcn_fence(__ATOMIC_ACQUIRE, "agent");
            xb_add(&bar[XB_XGEN(b.x)], 1u);
            asm volatile("s_waitcnt vmcnt(0)" ::: "memory");
        } else {
            XB_SPIN(xb_ld(&bar[XB_XGEN(b.x)]) == gen, bar);
            __builtin_amdgcn_fence(__ATOMIC_ACQUIRE, "agent");
            asm volatile("s_waitcnt vmcnt(0)" ::: "memory");
        }
    }
    __syncthreads();
}

__device__ __forceinline__ void transpose_item(const float* W, int K, int N, bf16_t* WT, int rstride, int roff, LAS float* scr, int item, int lane) {
    const int nblk = N / 32, kb = item / nblk, nb = item % nblk, k0 = 64 * kb, n0 = 32 * nb;
    float tv[32];
#pragma unroll
    for (int i = 0; i < 32; ++i) { const int kk = 2 * i + (lane >> 5); tv[i] = W[(size_t)(k0 + kk) * N + n0 + (lane & 31)]; }
#pragma unroll
    for (int i = 0; i < 32; ++i) { const int kk = 2 * i + (lane >> 5); scr[kk * 33 + (lane & 31)] = tv[i]; }
    LDS_WAIT();
    const int c = lane & 7;
#pragma unroll
    for (int j = 0; j < 4; ++j) { const int n = (lane >> 3) + 8 * j; const LAS float* s = scr + (8 * c) * 33 + n;
        u32x4 o; o.x = pk2(s[0 * 33], s[1 * 33]); o.y = pk2(s[2 * 33], s[3 * 33]); o.z = pk2(s[4 * 33], s[5 * 33]); o.w = pk2(s[6 * 33], s[7 * 33]);
        const int nn = n0 + n, drow = (nn >> 7) * rstride + (nn & 127) + roff;
        *(u32x4*)(WT + (size_t)drow * K + k0 + 8 * c) = o; }
    LDS_WAIT();
}
constexpr int I_GU = 16 * 88, I_DN = 44 * 32, I_IN = 16 * 64, I_OUT = 16 * 32, I_MOD = 16 * 288, I_LW = 6 * I_GU + I_IN + I_OUT;
static_assert(I_GU == I_DN, "items");
constexpr int I_DEF = 2752;
__device__ __forceinline__ void transpose_layer_item(ArgsP a, int l, int r, LAS float* scr, int lane) {
    unsigned char* wl = a->ws + WS_WL + (size_t)l * WL_STRIDE;
    const float* src; bf16_t* dst; int K = D, N = FF, rs = 256, ro = 0;
    if (r < 0) { r += I_MOD; src = a->in[11] + (size_t)l * D * NMODL; dst = (bf16_t*)(a->ws + WS_WMOD) + (size_t)l * NMODL * D; N = NMODL; rs = 128; }
    else if (r < I_GU) { src = a->in[13] + (size_t)l * D * FF; dst = (bf16_t*)(wl + WL_GU1); }
    else if (r < 2 * I_GU) { r -= I_GU; src = a->in[14] + (size_t)l * D * FF; dst = (bf16_t*)(wl + WL_GU1); ro = 128; }
    else if (r < 3 * I_GU) { r -= 2 * I_GU; src = a->in[15] + (size_t)l * FF * D; dst = (bf16_t*)(wl + WL_D1); K = FF; N = D; rs = 128; }
    else if (r < 3 * I_GU + I_IN) { r -= 3 * I_GU; src = a->in[16] + (size_t)l * D * INW; dst = (bf16_t*)(wl + WL_WIN); N = INW; rs = 128; }
    else if (r < 3 * I_GU + I_IN + I_OUT) { r -= 3 * I_GU + I_IN; src = a->in[17] + (size_t)l * D * D; dst = (bf16_t*)(wl + WL_WOUT); N = D; rs = 128; }
    else if (r < 4 * I_GU + I_IN + I_OUT) { r -= 3 * I_GU + I_IN + I_OUT; src = a->in[24] + (size_t)l * D * FF; dst = (bf16_t*)(wl + WL_GU2); }
    else if (r < 5 * I_GU + I_IN + I_OUT) { r -= 4 * I_GU + I_IN + I_OUT; src = a->in[25] + (size_t)l * D * FF; dst = (bf16_t*)(wl + WL_GU2); ro = 128; }
    else { r -= 5 * I_GU + I_IN + I_OUT; src = a->in[26] + (size_t)l * FF * D; dst = (bf16_t*)(wl + WL_D2); K = FF; N = D; rs = 128; }
    transpose_item(src, K, N, dst, rs, ro, scr, r, lane);
}
__device__ __forceinline__ void deferred_transposes(ArgsP a, LAS unsigned char* lds, int l_next, int half, int first_idle, int tid, int G, int bx) {
    if (bx < first_idle) return;
    const int wave = tid >> 6, lane = tid & 63, wv = (bx - first_idle) * 8 + wave, NW = (G - first_idle) * 8;
    LAS float* scr = (LAS float*)(lds + wave * 16384);
    for (int it = half * (I_LW / 2) + wv; it < half * (I_LW / 2) + I_DEF; it += NW) transpose_layer_item(a, l_next, it, scr, lane);
}
__device__ __forceinline__ void phase_prologue(ArgsP a, LAS unsigned char* lds, int tid, int G, int bx) {
    const int wave = tid >> 6, lane = tid & 63, gw = bx * 8 + wave, NGW = G * 8;
    LAS float* scr = (LAS float*)(lds + wave * 16384);
    constexpr int I_REST = I_LW / 2 - I_DEF, N_A = DEPTH * I_MOD, N_B = N_A + I_LW, N_C = N_B + 3 * 2 * I_REST;
    for (int it = gw; it < N_C; it += NGW) { int l, r;
        if (it < N_A) { l = it / I_MOD; r = it % I_MOD - I_MOD; }
        else if (it < N_B) { l = 0; r = it - N_A; }
        else { const int q = it - N_B, lh = q / I_REST; l = 1 + (lh >> 1); r = (lh & 1) * (I_LW / 2) + I_DEF + q % I_REST; }
        transpose_layer_item(a, l, r, scr, lane); }
    const int gt = bx * 512 + tid, NT = G * 512;
    bf16_t* SC = (bf16_t*)(a->ws + WS_SC);
    for (int i = gt; i < 256 * D; i += NT) { const int r = i >> 10, d = i & 1023; float v = 0.f;
        if (r < 8) v = silu_p(a->in[2][r * D + d]); else if (r < 136) v = silu_p(a->in[3][(r - 8) * D + d]);
        SC[i] = (bf16_t)f2bf(v); }
    if (bx == 0) { unsigned* bw = (unsigned*)a->ws; for (int i = tid; i < XCD_BAR_WORDS; i += 512) bw[i] = 0u; }
    if (bx == 0 && tid < 256) { float* LBS = (float*)(a->ws + WS_LBS); const float* hl = a->in[20];
        const float a0 = hl[tid], a1 = hl[256 + tid], a2 = hl[512 + tid], a3 = hl[768 + tid]; const float mx = fmaxf(fmaxf(a0, a1), fmaxf(a2, a3));
        const float e0 = expf(a0 - mx), e1 = expf(a1 - mx), e2 = expf(a2 - mx), e3 = expf(a3 - mx), s = e0 + e1 + e2 + e3;
        LBS[tid] = 0.f; LBS[256 + tid] = e1 / s; LBS[512 + tid] = (e1 + e2) / s; LBS[768 + tid] = (e1 + e2 + e3) / s; }
}

template <bool FINAL>
__device__ __forceinline__ void phase_norm(ArgsP a, const float* nw, int modcol, bool first, int tid, int G, int bx) {
    const int wave = tid >> 6, lane = tid & 63, gw = bx * 8 + wave, NGW = G * 8;
    float* X = a->out; bf16_t* H = (bf16_t*)(a->ws + WS_H); const float* MOD = (const float*)(a->ws + WS_MOD);
    f32x4 nv[4];
#pragma unroll
    for (int j = 0; j < 4; ++j) nv[j] = ((const f32x4*)nw)[lane + 64 * j];
    for (int row = 2 * gw; row < MT; row += 2 * NGW) {
        f32x4* xr = (f32x4*)(X + (size_t)row * D) + lane; f32x4 v[2][4]; float s0 = 0.f, s1 = 0.f;
        const f32x4* xs = first ? (const f32x4*)(row < MP ? a->in[0] + (size_t)row * D : a->in[1] + (size_t)(row - MP) * D) + lane : xr;
#pragma unroll
        for (int j = 0; j < 4; ++j) { v[0][j] = xs[64 * j]; v[1][j] = xs[256 + 64 * j]; }
        f32x4 sh[4], sc[4];
        if (!FINAL) { const float* mp = MOD + (size_t)pg8::row_batch(row) * NMOD + modcol;
#pragma unroll
            for (int j = 0; j < 4; ++j) { sh[j] = ((const f32x4*)mp)[lane + 64 * j]; sc[j] = ((const f32x4*)(mp + D))[lane + 64 * j]; } }
#pragma unroll
        for (int j = 0; j < 4; ++j) { s0 += (v[0][j].x * v[0][j].x + v[0][j].y * v[0][j].y) + (v[0][j].z * v[0][j].z + v[0][j].w * v[0][j].w);
            s1 += (v[1][j].x * v[1][j].x + v[1][j].y * v[1][j].y) + (v[1][j].z * v[1][j].z + v[1][j].w * v[1][j].w); }
        s0 = wave_sum(s0); s1 = wave_sum(s1);
        const float r0 = __builtin_amdgcn_rsqf(s0 * (1.0f / D) + EPS), r1 = __builtin_amdgcn_rsqf(s1 * (1.0f / D) + EPS);
        if (FINAL) {
#pragma unroll
            for (int j = 0; j < 4; ++j) { xr[64 * j] = (v[0][j] * r0) * nv[j]; xr[256 + 64 * j] = (v[1][j] * r1) * nv[j]; }
        } else {
            unsigned long long* o8 = (unsigned long long*)(H + (size_t)row * D) + lane;
#pragma unroll
            for (int j = 0; j < 4; ++j) { const f32x4 c = nv[j] * (sc[j] + 1.0f);
                const f32x4 h0 = ((v[0][j] * r0) * nv[j]) * (sc[j] + 1.0f) + sh[j], h1 = ((v[1][j] * r1) * nv[j]) * (sc[j] + 1.0f) + sh[j]; (void)c;
                o8[64 * j] = (unsigned long long)pk2(h0.x, h0.y) | ((unsigned long long)pk2(h0.z, h0.w) << 32);
                o8[256 + 64 * j] = (unsigned long long)pk2(h1.x, h1.y) | ((unsigned long long)pk2(h1.z, h1.w) << 32); }
        }
    }
}

__device__ __forceinline__ void attn_prompt_item(LAS unsigned char* lds, const bf16_t* Z, bf16_t* Y, const float* sinks, const float* relb, int item, int tid) {
    const int b = item >> 6, qblk = (item >> 1) & 31, kvh = item & 1, q0 = qblk * 64, rowbase = b * TP;
    LAS unsigned char* Ks = lds;
    LAS bf16_t* Vt = (LAS bf16_t*)(lds + 27648);
    LAS float* tab = (LAS float*)(lds + 27648 + 25088);
    const int w = tid >> 6, lane = tid & 63, hl = w >> 1, qsub = w & 1, head = kvh * 4 + hl, r = lane & 31, hi = lane >> 5;
    const int qi = qsub * 32 + r; const size_t qrow = (size_t)rowbase + q0 + qi;
    bf16x8 qf[4];
#pragma unroll
    for (int s = 0; s < 4; ++s) qf[s] = *(const bf16x8*)(Z + qrow * INW + OFF_AQ + head * 64 + 16 * s + 8 * hi);
    u32x4 kv[3], vv[3];
#pragma unroll
    for (int i = 0; i < 3; ++i) { const int ch = tid + i * 512, key = ch >> 3, c8 = ch & 7, kp = max(q0 - 128 + key, 0);
        const bf16_t* zr = Z + (size_t)(rowbase + kp) * INW + kvh * 64 + c8 * 8; kv[i] = *(const u32x4*)(zr + OFF_AK); vv[i] = *(const u32x4*)(zr + OFF_AV); }
#pragma unroll
    for (int i = 0; i < 3; ++i) {
        const int ch = tid + i * 512, key = ch >> 3, c8 = ch & 7;
        if (q0 - 128 + key < 0) { kv[i] = (u32x4){0u, 0u, 0u, 0u}; vv[i] = (u32x4){0u, 0u, 0u, 0u}; }
        *(LAS u32x4*)(Ks + key * 144 + c8 * 16) = kv[i];
#pragma unroll
        for (int e = 0; e < 8; ++e) Vt[(c8 * 8 + e) * 196 + key] = (bf16_t)((vv[i][e >> 1] >> (16 * (e & 1))) & 0xffffu);
    }
    { const int hl = tid >> 7, n = tid & 127; tab[tid] = relb[(int)c_bucket[n] * 8 + kvh * 4 + hl]; }
    __syncthreads();
    const float sink = sinks[head]; const unsigned nlim = (unsigned)min(127, q0 + qi);
    float mx = -INFINITY;
#pragma unroll 1
    for (int tt = 0; tt < 5; ++tt) { f32x16 acc;
#pragma unroll
        for (int i = 0; i < 16; ++i) acc[i] = 0.f;
        const LAS unsigned char* kb = Ks + ((qsub + tt) * 32 + r) * 144 + 16 * hi;
#pragma unroll
        for (int s = 0; s < 4; ++s) { const bf16x8 kf = *(const LAS bf16x8*)(kb + 32 * s); acc = __builtin_amdgcn_mfma_f32_32x32x16_bf16(kf, qf[s], acc, 0, 0, 0); }
        const int nb = r + 128 - tt * 32 - 4 * hi; const LAS float* tb = tab + hl * 128;
#pragma unroll
        for (int i = 0; i < 16; ++i) { const int n = nb - ((i & 3) + 8 * (i >> 2));
            const float lg = acc[i] * 0.125f + tb[n & 127]; mx = fmaxf(mx, ((unsigned)n <= nlim) ? lg : -INFINITY); } }
    mx = fmaxf(mx, __shfl_xor(mx, 32)); mx = fmaxf(mx, sink);
    float sum = 0.f;
    f32x16 oacc[2];
#pragma unroll
    for (int dt = 0; dt < 2; ++dt)
#pragma unroll
        for (int i = 0; i < 16; ++i) oacc[dt][i] = 0.f;
#pragma unroll 1
    for (int tt = 0; tt < 5; ++tt) { f32x16 acc;
#pragma unroll
        for (int i = 0; i < 16; ++i) acc[i] = 0.f;
        const LAS unsigned char* kb = Ks + ((qsub + tt) * 32 + r) * 144 + 16 * hi;
#pragma unroll
        for (int s = 0; s < 4; ++s) { const bf16x8 kf = *(const LAS bf16x8*)(kb + 32 * s); acc = __builtin_amdgcn_mfma_f32_32x32x16_bf16(kf, qf[s], acc, 0, 0, 0); }
        const int nb = r + 128 - tt * 32 - 4 * hi; const LAS float* tb = tab + hl * 128;
#pragma unroll
        for (int i = 0; i < 16; ++i) { const int n = nb - ((i & 3) + 8 * (i >> 2));
            const float lg = acc[i] * 0.125f + tb[n & 127]; const float p = ((unsigned)n <= nlim) ? __expf(lg - mx) : 0.f; acc[i] = p; sum += p; }
#pragma unroll
        for (int s = 0; s < 2; ++s) {
            u32x4 pw; pw.x = pk2(acc[8 * s + 0], acc[8 * s + 1]); pw.y = pk2(acc[8 * s + 2], acc[8 * s + 3]); pw.z = pk2(acc[8 * s + 4], acc[8 * s + 5]); pw.w = pk2(acc[8 * s + 6], acc[8 * s + 7]);
            const bf16x8 pf = __builtin_bit_cast(bf16x8, pw);
#pragma unroll
            for (int dt = 0; dt < 2; ++dt) { const LAS bf16_t* vp = Vt + (dt * 32 + r) * 196 + (qsub + tt) * 32 + 16 * s + 4 * hi;
                const u32x2 lo = *(const LAS u32x2*)vp, hh = *(const LAS u32x2*)(vp + 8); u32x4 vw; vw.x = lo.x; vw.y = lo.y; vw.z = hh.x; vw.w = hh.y;
                oacc[dt] = __builtin_amdgcn_mfma_f32_32x32x16_bf16(__builtin_bit_cast(bf16x8, vw), pf, oacc[dt], 0, 0, 0); }
        } }
    sum += __shfl_xor(sum, 32);
    const float inv = __builtin_amdgcn_rcpf(sum + __expf(sink - mx));
    bf16_t* yr = Y + qrow * D + 512 + head * 64;
#pragma unroll
    for (int dt = 0; dt < 2; ++dt)
#pragma unroll
        for (int g4 = 0; g4 < 4; ++g4) { u32x2 o; o.x = pk2(oacc[dt][4 * g4 + 0] * inv, oacc[dt][4 * g4 + 1] * inv); o.y = pk2(oacc[dt][4 * g4 + 2] * inv, oacc[dt][4 * g4 + 3] * inv);
            *(u32x2*)(yr + dt * 32 + 8 * g4 + 4 * hi) = o; }
    __syncthreads();
}
__device__ __forceinline__ void attn_sample_item(LAS unsigned char* lds, ArgsP a, int l, const bf16_t* Z, bf16_t* Y, const float* sinks, const float* relb, int item, int tid) {
    const int b = item >> 1, kvh = item & 1;
    LAS float* Kx = (LAS float*)lds;
    LAS float* Vx = (LAS float*)(lds + 35904);
    LAS float* Qs = (LAS float*)(lds + 69696);
    LAS float* Ps = (LAS float*)(lds + 73792);
    LAS float* tab = (LAS float*)(lds + 82496);
    const size_t cbase = (size_t)(l * 128 + b) * 128 * 128;
    const float* ck = a->in[6] + cbase; const float* cv = a->in[7] + cbase; float* nk = a->out + O_KS + cbase; float* nv = a->out + O_VS + cbase;
    { float kx[16], vx[16]; const int d = tid & 63, j0 = tid >> 6;
#pragma unroll
      for (int i = 0; i < 16; ++i) { kx[i] = ck[(j0 + 8 * i) * 128 + kvh * 64 + d]; vx[i] = cv[(j0 + 8 * i) * 128 + kvh * 64 + d]; }
      unsigned zk = 0, zv = 0, zq0, zq1;
      { const int t = (tid >> 6) & 3; const bf16_t* zr = Z + (size_t)(MP + b * 4 + t) * INW + kvh * 64 + d; zk = zr[OFF_AK]; zv = zr[OFF_AV]; }
      { const int rr = tid >> 6, hl = rr >> 2, t = rr & 3; zq0 = Z[(size_t)(MP + b * 4 + t) * INW + OFF_AQ + (kvh * 4 + hl) * 64 + d]; zq1 = Z[(size_t)(MP + b * 4 + t) * INW + OFF_AQ + (kvh * 4 + hl + 2) * 64 + d]; }
#pragma unroll
      for (int i = 0; i < 16; ++i) { const int j = j0 + 8 * i; Kx[j * 68 + d] = kx[i]; Vx[j * 64 + d] = vx[i];
          if (j >= 4) { nk[(j - 4) * 128 + kvh * 64 + d] = kx[i]; nv[(j - 4) * 128 + kvh * 64 + d] = vx[i]; } }
      if (tid < 256) { const int t = tid >> 6; const float k1 = bf2f(zk), v1 = bf2f(zv);
          Kx[(128 + t) * 68 + d] = k1; Vx[(128 + t) * 64 + d] = v1; nk[(124 + t) * 128 + kvh * 64 + d] = k1; nv[(124 + t) * 128 + kvh * 64 + d] = v1; }
      Qs[tid] = bf2f(zq0); Qs[tid + 512] = bf2f(zq1); }
    { const int hl = tid >> 7, n = tid & 127; tab[tid] = relb[(int)c_bucket[n] * 8 + kvh * 4 + hl]; }
    __syncthreads();
    const int w = tid >> 6, lane = tid & 63;
#pragma unroll
    for (int r2 = 0; r2 < 2; ++r2) { const int row = 2 * w + r2, hl = row >> 2, t = row & 3; const float sink = sinks[kvh * 4 + hl];
        float lg[3]; float mx = -INFINITY;
#pragma unroll
        for (int ps = 0; ps < 3; ++ps) { const int key = lane + 64 * ps; float v = -INFINITY;
            if (key < 132) { float dot = 0.f; const LAS f32x4* q4 = (const LAS f32x4*)(Qs + row * 64); const LAS f32x4* k4 = (const LAS f32x4*)(Kx + key * 68);
#pragma unroll
                for (int d = 0; d < 16; ++d) { const f32x4 qa = q4[d], ka = k4[d]; dot += (qa.x * ka.x + qa.y * ka.y) + (qa.z * ka.z + qa.w * ka.w); }
                const int n = t + 128 - key; if (n >= 0 && n < 128) v = dot * 0.125f + tab[hl * 128 + n]; }
            lg[ps] = v; mx = fmaxf(mx, v); }
        mx = fmaxf(wave_max(mx), sink);
        float p[3], sum = 0.f;
#pragma unroll
        for (int ps = 0; ps < 3; ++ps) { p[ps] = __expf(lg[ps] - mx); sum += p[ps]; }
        const float inv = __builtin_amdgcn_rcpf(wave_sum(sum) + __expf(sink - mx));
#pragma unroll
        for (int ps = 0; ps < 3; ++ps) { const int key = lane + 64 * ps; if (key < 132) Ps[row * 136 + key] = p[ps] * inv; }
        LDS_WAIT();
        float o = 0.f;
#pragma unroll 4
        for (int key = 0; key < 132; ++key) o += Ps[row * 136 + key] * Vx[key * 64 + lane];
        Y[(size_t)(MP + b * 4 + t) * D + 512 + (kvh * 4 + hl) * 64 + lane] = (bf16_t)f2bf(o);
    }
    __syncthreads();
}

__device__ __forceinline__ void pool_item(LAS unsigned char* lds, const bf16_t* Z, bf16_t* Y, const float* pw, const float* psc, bool sample, int rowbase, int t0, const float* prefix, float* newpool, int tid) {
    const int ntok = sample ? 4 : 32, nrows = ntok + 15, tph = ntok >> 1;
    LAS float* ext = (LAS float*)lds;
    LAS float* dbuf = (LAS float*)(lds + 48128);
    if (sample) {
        f32x4 p0[2], p1[2]; u32x4 zz = {0u, 0u, 0u, 0u};
#pragma unroll
        for (int k = 0; k < 2; ++k) { const int c = min(tid + k * 512, 479), i = c >> 5, c8 = c & 31; p0[k] = *(const f32x4*)(prefix + i * 256 + c8 * 8); p1[k] = *(const f32x4*)(prefix + i * 256 + c8 * 8 + 4); }
        if (tid < 128) zz = *(const u32x4*)(Z + (size_t)(rowbase + (tid >> 5)) * INW + (tid & 31) * 8);
#pragma unroll
        for (int k = 0; k < 2; ++k) { const int c = tid + k * 512; if (c < 480) { const int i = c >> 5, c8 = c & 31; *(LAS f32x4*)(ext + i * 256 + c8 * 8) = p0[k]; *(LAS f32x4*)(ext + i * 256 + c8 * 8 + 4) = p1[k]; } }
        if (tid < 128) { const int i = 15 + (tid >> 5), c8 = tid & 31; f32x4 v0, v1;
            v0.x = bf2f(zz.x & 0xffffu); v0.y = bf2f(zz.x >> 16); v0.z = bf2f(zz.y & 0xffffu); v0.w = bf2f(zz.y >> 16); v1.x = bf2f(zz.z & 0xffffu); v1.y = bf2f(zz.z >> 16); v1.z = bf2f(zz.w & 0xffffu); v1.w = bf2f(zz.w >> 16);
            *(LAS f32x4*)(ext + i * 256 + c8 * 8) = v0; *(LAS f32x4*)(ext + i * 256 + c8 * 8 + 4) = v1; }
    } else {
        u32x4 zz[3];
#pragma unroll
        for (int k = 0; k < 3; ++k) { const int c = min(tid + k * 512, 1503), i = c >> 5, c8 = c & 31, tl = max(i - 15, -t0); zz[k] = *(const u32x4*)(Z + (size_t)(rowbase + tl) * INW + c8 * 8); }
#pragma unroll
        for (int k = 0; k < 3; ++k) { const int c = tid + k * 512; if (c < 1504) { const int i = c >> 5, c8 = c & 31; u32x4 z = zz[k]; if (t0 + i - 15 < 0) z = (u32x4){0u, 0u, 0u, 0u}; f32x4 v0, v1;
            v0.x = bf2f(z.x & 0xffffu); v0.y = bf2f(z.x >> 16); v0.z = bf2f(z.y & 0xffffu); v0.w = bf2f(z.y >> 16); v1.x = bf2f(z.z & 0xffffu); v1.y = bf2f(z.z >> 16); v1.z = bf2f(z.w & 0xffffu); v1.w = bf2f(z.w >> 16);
            *(LAS f32x4*)(ext + i * 256 + c8 * 8) = v0; *(LAS f32x4*)(ext + i * 256 + c8 * 8 + 4) = v1; } }
    }
    __syncthreads();
    const int ch = tid & 255, half = tid >> 8, g = ch >> 6, wlen = 2 << g, gd = ch & 63;
    { const int tb0 = half * tph; const LAS float* ep = ext + (15 + tb0) * 256 + ch; float s = 0.f;
#pragma unroll
      for (int q = 0; q < 16; ++q) { const float v = ep[-q * 256]; s += (q < wlen) ? v : 0.f; }
#pragma unroll
      for (int tt = 0; tt < 16; ++tt) if (tt < tph) { const float cur = ep[tt * 256];
          if (tt > 0) s += cur - ep[(tt - wlen) * 256];
          const int cnt = sample ? wlen : min(t0 + tb0 + tt + 1, wlen);
          dbuf[(tb0 + tt) * 256 + ch] = s * __builtin_amdgcn_rcpf((float)cnt) - cur; } }
    if (newpool) for (int idx = tid; idx < 15 * 256; idx += 512) newpool[idx] = ext[(nrows - 15) * 256 + idx];
    __syncthreads();
    float acc[16];
#pragma unroll
    for (int tt = 0; tt < 16; ++tt) acc[tt] = 0.f;
    const float* wp = pw + (size_t)(g * 64) * 64 + gd;
    float wa0 = wp[0], wa1 = wp[64], wa2 = wp[128], wa3 = wp[192], wb0 = wp[256], wb1 = wp[320], wb2 = wp[384], wb3 = wp[448];
#pragma unroll 1
    for (int c4 = 0; c4 < 16; ++c4) {
        const float* wn = wp + (size_t)min(c4 + 2, 15) * 256; const float wc0 = wn[0], wc1 = wn[64], wc2 = wn[128], wc3 = wn[192];
        const LAS float* dp = dbuf + (half * tph) * 256 + g * 64 + c4 * 4;
#pragma unroll
        for (int tt = 0; tt < 16; ++tt) if (tt < tph) { const f32x4 d4 = *(const LAS f32x4*)(dp + tt * 256);
            acc[tt] += (d4.x * wa0 + d4.y * wa1) + (d4.z * wa2 + d4.w * wa3); }
        wa0 = wb0; wa1 = wb1; wa2 = wb2; wa3 = wb3; wb0 = wc0; wb1 = wc1; wb2 = wc2; wb3 = wc3;
    }
    const float sc = psc[ch];
#pragma unroll
    for (int tt = 0; tt < 16; ++tt) if (tt < tph) Y[(size_t)(rowbase + half * tph + tt) * D + ch] = (bf16_t)f2bf(acc[tt] * sc);
    __syncthreads();
}

template <bool OUT, int NSTEPS>
__device__ __forceinline__ void hgrn_run(LAS float* wl, const bf16_t* Z, bf16_t* Y, int row0, int h, float lbv, float hgn, f32x2 (&S)[32], float& P, int lane) {
    LAS float* fb = wl; LAS float* qb = wl + 1024; LAS unsigned* vg = (LAS unsigned*)(wl + 2048); LAS float* obuf = wl + 3072;
    const LAS f32x4* fb4 = (const LAS f32x4*)fb; const LAS f32x4* qb4 = (const LAS f32x4*)qb;
    constexpr int nst = NSTEPS < 16 ? NSTEPS : 16; static_assert(NSTEPS <= 16 || NSTEPS % 16 == 0, "steps");
    for (int t0 = 0; t0 < NSTEPS; t0 += 16) {
        unsigned rf[nst], ri[nst], rq[nst], rg[nst];
#pragma unroll
        for (int tt = 0; tt < nst; ++tt) { const bf16_t* zr = Z + (size_t)(row0 + t0 + tt) * INW + h * 64 + lane;
            rf[tt] = zr[OFF_HF]; ri[tt] = zr[OFF_HI]; if (OUT) { rq[tt] = zr[OFF_HQ]; rg[tt] = zr[OFF_HG]; } }
#pragma unroll
        for (int tt = 0; tt < nst; ++tt) {
            const float f = lbv + (1.0f - lbv) * __builtin_amdgcn_rcpf(1.0f + __expf(-bf2f(rf[tt]))); fb[tt * 64 + lane] = f; P *= f;
            unsigned pv = ri[tt];
            if (OUT) { qb[tt * 64 + lane] = silu_p(bf2f(rq[tt])); pv |= rg[tt] << 16; }
            vg[tt * 64 + lane] = pv; }
        LDS_WAIT();
        f32x4 fA[4], qA[4], fB[4], qB[4];
#pragma unroll
        for (int i = 0; i < 4; ++i) { fA[i] = fb4[i]; if (OUT) qA[i] = qb4[i]; }
#define HG_PART(FX, QX, base) _Pragma("unroll") for (int i = 0; i < 4; ++i) { const f32x2 f0 = __builtin_shufflevector(FX[i], FX[i], 0, 1), f1 = __builtin_shufflevector(FX[i], FX[i], 2, 3); \
                S[(base) + 2 * i] = f0 * (S[(base) + 2 * i] - v2) + v2; S[(base) + 2 * i + 1] = f1 * (S[(base) + 2 * i + 1] - v2) + v2; \
                if (OUT) { oa += S[(base) + 2 * i] * __builtin_shufflevector(QX[i], QX[i], 0, 1); ob += S[(base) + 2 * i + 1] * __builtin_shufflevector(QX[i], QX[i], 2, 3); } }
#define HG_LOAD(FX, QX, idx) _Pragma("unroll") for (int i = 0; i < 4; ++i) { FX[i] = fb4[(idx) + i]; if (OUT) QX[i] = qb4[(idx) + i]; }
#pragma unroll 1
        for (int tt = 0; tt < nst; ++tt) {
            const unsigned pv = vg[tt * 64 + lane]; const float v = bf2f(pv & 0xffffu); const f32x2 v2 = {v, v};
            f32x2 oa = {0.f, 0.f}, ob = {0.f, 0.f};
            const int tn = min(tt + 1, 15);
            HG_LOAD(fB, qB, tt * 16 + 4);  HG_PART(fA, qA, 0);
            HG_LOAD(fA, qA, tt * 16 + 8);  HG_PART(fB, qB, 8);
            HG_LOAD(fB, qB, tt * 16 + 12); HG_PART(fA, qA, 16);
            HG_LOAD(fA, qA, tn * 16);      HG_PART(fB, qB, 24);
            if (OUT) obuf[tt * 64 + lane] = (oa.x + oa.y) + (ob.x + ob.y);
        }
        if (OUT) {
#pragma unroll
            for (int tt = 0; tt < 16; ++tt) if (tt < nst) { const float o = obuf[tt * 64 + lane]; const float ms = wave_sum(o * o) * (1.0f / 64.0f); const float on = o * __builtin_amdgcn_rsqf(ms + EPS) * hgn;
                Y[(size_t)(row0 + t0 + tt) * D + 256 + h * 64 + lane] = (bf16_t)f2bf(on * silu_p(bf2f(vg[tt * 64 + lane] >> 16))); }
        }
#undef HG_PART
#undef HG_LOAD
        LDS_WAIT();
    }
}

__device__ __forceinline__ void phase_mix1(ArgsP a, LAS unsigned char* lds, int l, int tid, int G, int bx) {
    const bf16_t* Z = (const bf16_t*)(a->ws + WS_Z); bf16_t* Y = (bf16_t*)(a->ws + WS_Y);
    const float* sinks = a->in[22] + l * 8; const float* relb = a->in[23];
for (int rp_ = 0; rp_ < (MIXPROBE == 1 ? 2 : 1); ++rp_) {
        for (int it = bx; it < 512; it += G) attn_prompt_item(lds, Z, Y, sinks, relb, it, tid);
    }
for (int rp_ = 0; rp_ < (MIXPROBE == 2 ? 2 : 1); ++rp_) {
        for (int it = bx; it < 256; it += G) attn_sample_item(lds, a, l, Z, Y, sinks, relb, it, tid);
    }
    const float* pw = a->in[18] + (size_t)l * 4 * 64 * 64; const float* psc = a->in[19] + l * 256;
for (int rp_ = 0; rp_ < (MIXPROBE == 3 ? 2 : 1); ++rp_) {
        for (int it = bx; it < 512; it += G) { const int b = it >> 6, tb = it & 63;
        pool_item(lds, Z, Y, pw, psc, false, b * TP + tb * 32, tb * 32, nullptr, tb == 63 ? a->out + O_POOLP + (size_t)(l * 8 + b) * 15 * 256 : nullptr, tid); }
    for (int it = bx; it < 128; it += G)
        pool_item(lds, Z, Y, pw, psc, true, MP + it * 4, 0, a->in[4] + (size_t)(l * 128 + it) * 15 * 256, a->out + O_POOLS + (size_t)(l * 128 + it) * 15 * 256, tid);
    }
    { const int gt = bx * 512 + tid, NT = G * 512; float* okp = a->out + O_KP + (size_t)l * 8 * 128 * 128; float* ovp = a->out + O_VP + (size_t)l * 8 * 128 * 128;
      for (int i = gt; i < 8 * 128 * 128; i += NT) { const int c = i & 127, j = (i >> 7) & 127, b = i >> 14; const bf16_t* zr = Z + (size_t)(b * TP + 1920 + j) * INW + c;
          okp[i] = bf2f(zr[OFF_AK]); ovp[i] = bf2f(zr[OFF_AV]); } }
    const int wave = tid >> 6, lane = tid & 63, gw = bx * 8 + wave, NGW = G * 8;
    LAS float* wl = (LAS float*)(lds + wave * 16384);
    const float* LBS = (const float*)(a->ws + WS_LBS) + l * 256; float* HU = (float*)(a->ws + WS_HU); float* HP = (float*)(a->ws + WS_HP);
for (int rp_ = 0; rp_ < (MIXPROBE == 4 ? 2 : 1); ++rp_) {
        for (int it = gw; it < 32 * HNC; it += NGW) { const int sq = it / HNC, c = it % HNC, b = sq >> 2, h = sq & 3;
        f32x2 S[32]; float P = 1.0f;
#pragma unroll
        for (int k = 0; k < 32; ++k) S[k] = (f32x2){0.f, 0.f};
        hgrn_run<false, HL>(wl, Z, Y, b * TP + c * HL, h, LBS[h * 64 + lane], 0.f, S, P, lane);
        float* up = HU + (size_t)it * 4096 + lane;
#pragma unroll
        for (int k = 0; k < 64; ++k) up[k * 64] = S[k >> 1][k & 1];
        HP[(size_t)it * 64 + lane] = P; }
    }
    const float hgn = a->in[21][l * 64 + lane];
for (int rp_ = 0; rp_ < (MIXPROBE == 5 ? 2 : 1); ++rp_) {
        for (int it = gw; it < 512; it += NGW) { const int b = it >> 2, h = it & 3;
        const float* s0 = a->in[5] + (size_t)((l * 128 + b) * 4 + h) * 4096 + lane; f32x2 S[32]; float P = 1.0f;
#pragma unroll
        for (int k = 0; k < 64; ++k) S[k >> 1][k & 1] = s0[k * 64];
        hgrn_run<true, 4>(wl, Z, Y, MP + b * 4, h, LBS[h * 64 + lane], hgn, S, P, lane);
        float* so = a->out + O_HGS + (size_t)((l * 128 + b) * 4 + h) * 4096 + lane;
#pragma unroll
        for (int k = 0; k < 64; ++k) so[k * 64] = S[k >> 1][k & 1]; }
    }
}
__device__ __forceinline__ void phase_mix2(ArgsP a, int tid, int G, int bx) {
    float* HU = (float*)(a->ws + WS_HU); const float* HP = (const float*)(a->ws + WS_HP);
    for (int e = bx * 512 + tid; e < 32 * 4096; e += G * 512) { const int sq = e >> 12, idx = e & 4095, k = idx >> 6;
        float* up = HU + (size_t)sq * HNC * 4096 + idx; const float* pp = HP + (size_t)sq * HNC * 64 + k; float S = 0.f;
        for (int c0 = 0; c0 < HNC; c0 += 32) { float u[32], p[32];
#pragma unroll
            for (int i = 0; i < 32; ++i) { u[i] = up[(size_t)(c0 + i) * 4096]; p[i] = pp[(c0 + i) * 64]; }
#pragma unroll
            for (int i = 0; i < 32; ++i) { up[(size_t)(c0 + i) * 4096] = S; S = __builtin_fmaf(p[i], S, u[i]); } } }
}
__device__ __forceinline__ void phase_mix3(ArgsP a, LAS unsigned char* lds, int l, int tid, int G, int bx) {
    const bf16_t* Z = (const bf16_t*)(a->ws + WS_Z); bf16_t* Y = (bf16_t*)(a->ws + WS_Y);
    const int wave = tid >> 6, lane = tid & 63, gw = bx * 8 + wave, NGW = G * 8;
    LAS float* wl = (LAS float*)(lds + wave * 16384);
    const float* LBS = (const float*)(a->ws + WS_LBS) + l * 256; const float* HU = (const float*)(a->ws + WS_HU);
    const float hgn = a->in[21][l * 64 + lane];
    for (int it = gw; it < 32 * HNC; it += NGW) { const int sq = it / HNC, c = it % HNC, b = sq >> 2, h = sq & 3;
        const float* up = HU + (size_t)it * 4096 + lane; f32x2 S[32]; float P = 1.0f;
#pragma unroll
        for (int k = 0; k < 64; ++k) S[k >> 1][k & 1] = up[k * 64];
        hgrn_run<true, HL>(wl, Z, Y, b * TP + c * HL, h, LBS[h * 64 + lane], hgn, S, P, lane);
        if (c == HNC - 1) { float* so = a->out + O_HGP + (size_t)((l * 8 + b) * 4 + h) * 4096 + lane;
#pragma unroll
            for (int k = 0; k < 64; ++k) so[k * 64] = S[k >> 1][k & 1]; } }
}

struct SkResid { float* X; const float* Xin; const float* gate; int gpitch; float coef;
    __device__ __forceinline__ void operator()(int row, int col, f32x4 v) const { float* xp = X + (size_t)row * D + col; const float* gp = gate + (size_t)pg8::row_batch(row) * gpitch + col;
        f32x4 x = *(const f32x4*)(Xin + (size_t)row * D + col); x = x + (*(const f32x4*)gp * coef) * v; *(f32x4*)xp = x; } };
struct SkBf16 { bf16_t* O; int ldc;
    __device__ __forceinline__ void operator()(int row, int col, f32x4 v) const { u32x2 w; w.x = pk2(v.x, v.y); w.y = pk2(v.z, v.w); *(u32x2*)(O + (size_t)row * ldc + col) = w; } };
template <int SKB, class F>
__device__ __forceinline__ void skinny_gemm(LAS unsigned char* lds, const bf16_t* A, const bf16_t* Bt, int N, int K, int row_off, int tid, int bx, int G, const F& epi) {
    const int w = tid >> 6, lane = tid & 63, fr = lane & 15, fq = lane >> 4;
    const int ntn = N >> 6, ntiles = 16 * ntn, ksl = K >> 3, nks = ksl >> 5;
    LAS float* red = (LAS float*)lds;
    for (int tile = bx; tile < ntiles; tile += G) {
        const int tm = tile / ntn, tn = tile % ntn;
        f32x4 acc[2][4];
#pragma unroll
        for (int mi = 0; mi < 2; ++mi)
#pragma unroll
            for (int ni = 0; ni < 4; ++ni) acc[mi][ni] = (f32x4){0.f, 0.f, 0.f, 0.f};
        const bf16_t* ap = A + (size_t)(tm * 32 + fr) * K + w * ksl + fq * 8;
        const bf16_t* bp = Bt + (size_t)(tn * 64 + fr) * K + w * ksl + fq * 8;
        for (int s0 = 0; s0 < nks; s0 += SKB) {
            bf16x8 af[SKB][2], bfr[SKB][4];
#pragma unroll
            for (int s = 0; s < SKB; ++s) { const int ss = min(s0 + s, nks - 1);
#pragma unroll
                for (int mi = 0; mi < 2; ++mi) af[s][mi] = *(const bf16x8*)(ap + (size_t)mi * 16 * K + ss * 32);
#pragma unroll
                for (int ni = 0; ni < 4; ++ni) bfr[s][ni] = *(const bf16x8*)(bp + (size_t)ni * 16 * K + ss * 32); }
#pragma unroll
            for (int s = 0; s < SKB; ++s) if (s0 + s < nks) {
#pragma unroll
                for (int mi = 0; mi < 2; ++mi)
#pragma unroll
                    for (int ni = 0; ni < 4; ++ni) acc[mi][ni] = __builtin_amdgcn_mfma_f32_16x16x32_bf16(af[s][mi], bfr[s][ni], acc[mi][ni], 0, 0, 0); }
        }
#pragma unroll
        for (int mi = 0; mi < 2; ++mi)
#pragma unroll
            for (int ni = 0; ni < 4; ++ni)
#pragma unroll
                for (int r = 0; r < 4; ++r) red[(w * 32 + mi * 16 + fq * 4 + r) * 64 + ni * 16 + fr] = acc[mi][ni][r];
        __syncthreads();
        { const int row = tid >> 4, c4 = (tid & 15) * 4; f32x4 sum = {0.f, 0.f, 0.f, 0.f};
#pragma unroll
          for (int ww = 0; ww < 8; ++ww) sum = sum + *(const LAS f32x4*)(red + (ww * 32 + row) * 64 + c4);
          epi(row_off + tm * 32 + row, tn * 64 + c4, sum); }
        __syncthreads();
    }
}

constexpr int NPH = 2 + 12 * DEPTH + 1;
__global__ void __launch_bounds__(512, 2) fwd_kernel(Args a_) {
    extern __shared__ __attribute__((aligned(16))) unsigned char lds_raw[];
    LAS unsigned char* lds = (LAS unsigned char*)lds_raw;
    cg::grid_group grid = cg::this_grid();
    const int ph_lo = a_.ph_lo, ph_hi = a_.ph_hi;
    volatile LAS unsigned* MISC = (volatile LAS unsigned*)(lds + 131072 + 320);
    if (threadIdx.x < 2) MISC[threadIdx.x] = 0u;
    __syncthreads();
    XcdBarrier bar; bar.bar = (unsigned*)a_.ws; bar.x = 0; bar.st = MISC;
    for (int ph = ph_lo; ph < ph_hi; ++ph) {
        if (ph == ph_lo + 1) { grid.sync(); bar = xcd_barrier_post((unsigned*)a_.ws, MISC); }
        else if (ph > ph_lo + 1) xcd_barrier(bar);
        ArgsP a = (ArgsP)__builtin_amdgcn_kernarg_segment_ptr(); asm volatile("" : "+s"(a));
        int tid = threadIdx.x; asm volatile("" : "+v"(tid));
        int bx = blockIdx.x, G = gridDim.x; asm volatile("" : "+s"(bx), "+s"(G));
        bf16_t* Hb = (bf16_t*)(a->ws + WS_H); bf16_t* Gb = (bf16_t*)(a->ws + WS_G); bf16_t* Zb = (bf16_t*)(a->ws + WS_Z); bf16_t* Yb = (bf16_t*)(a->ws + WS_Y);
        float* MOD = (float*)(a->ws + WS_MOD);
        if (ph == 0) { phase_prologue(a, lds, tid, G, bx); continue; }
        if (ph == 1) { pg8::Gemm g{(const bf16_t*)(a->ws + WS_SC), (const bf16_t*)(a->ws + WS_WMOD), 256, NMOD, D}; pg8::StaticOrder S; S.init(256, NMOD, G, bx);
            pg8::EpiF32Bias E{MOD, NMOD, a->in[12], 136}; pg8::gemm_phase<pg8::EpiF32Bias, pg8::StaticOrder, false, true>(lds, g, S, E); continue; }
        if (ph == NPH - 1) { phase_norm<true>(a, a->in[27], 0, false, tid, G, bx); continue; }
        const int l = (ph - 2) / 12, s = (ph - 2) % 12;
        unsigned char* wl = a->ws + WS_WL + (size_t)l * WL_STRIDE;
        if (s == 0 || s == 3 || s == 9) { const int sub = s == 0 ? 0 : (s == 3 ? 1 : 2); const float* nw = s == 0 ? a->in[8] : (s == 3 ? a->in[9] : a->in[10]); phase_norm<false>(a, nw + l * D, l * NMODL + 3 * sub * D, ph == 2, tid, G, bx); }
        else if (s == 1 || s == 10) { pg8::Gemm g{Hb, (const bf16_t*)(wl + (s == 1 ? WL_GU1 : WL_GU2)), MT, 2 * FF, D}; pg8::StaticOrder S; S.init(MT, 2 * FF, G, bx);
            pg8::EpiSwiGLU E{Gb, FF}; pg8::gemm_phase<pg8::EpiSwiGLU, pg8::StaticOrder, true, true>(lds, g, S, E);
            if (l < DEPTH - 1) { __syncthreads(); deferred_transposes(a, lds, l + 1, s == 1 ? 0 : 1, ((MT / 256) * (2 * FF / 256)) % G, tid, G, bx); } }
        else if (s == 2 || s == 11 || s == 8) {
            const int Kd = s == 8 ? D : FF; const bf16_t* Ad = s == 8 ? Yb : Gb; const bf16_t* Bd = (const bf16_t*)(wl + (s == 2 ? WL_D1 : (s == 11 ? WL_D2 : WL_WOUT)));
            pg8::Gemm g{Ad, Bd, MP, D, Kd}; pg8::StaticOrder S; S.init(MP, D, G, bx);
            const bool first = (l == 0 && s == 2);
            pg8::EpiResid E{a->out, first ? a->in[0] : a->out, MOD + l * NMODL + (s == 2 ? 2 : (s == 8 ? 5 : 8)) * D, NMOD, s == 8 ? 1.0f : 0.5f}; pg8::gemm_phase<pg8::EpiResid, pg8::StaticOrder, false, true>(lds, g, S, E);
            __syncthreads();
            SkResid SE{a->out, first ? a->in[1] - (size_t)MP * D : a->out, E.gate, NMOD, E.coef}; if (s == 8) skinny_gemm<4>(lds, Ad + (size_t)MP * Kd, Bd, D, Kd, MP, tid, bx, G, SE); else skinny_gemm<6>(lds, Ad + (size_t)MP * Kd, Bd, D, Kd, MP, tid, bx, G, SE); }
        else if (s == 4) { pg8::Gemm g{Hb, (const bf16_t*)(wl + WL_WIN), MP, INW, D}; pg8::StaticOrder S; S.init(MP, INW, G, bx);
            pg8::EpiBf16<0> E{Zb, INW, nullptr, 0, 0, 1.f}; pg8::gemm_phase<pg8::EpiBf16<0>, pg8::StaticOrder, false, true>(lds, g, S, E);
            __syncthreads();
            SkBf16 SE{Zb, INW}; skinny_gemm<4>(lds, Hb + (size_t)MP * D, (const bf16_t*)(wl + WL_WIN), INW, D, MP, tid, bx, G, SE); }
        else if (s == 5) phase_mix1(a, lds, l, tid, G, bx);
        else if (s == 6) phase_mix2(a, tid, G, bx);
        else phase_mix3(a, lds, l, tid, G, bx);
    }
}

extern "C" void kernel_launch(void* const* d_in, const int* in_sizes, int n_in, void* d_out, int out_size, void* d_ws, size_t ws_size, hipStream_t stream) {
    static int grid = 0;
    if (grid == 0) {
        if (n_in != 28 || (size_t)out_size != O_END || ws_size < WS_END) { fprintf(stderr, "kernel_launch: unexpected shapes (n_in %d, out %d, ws %zu); nothing launched\n", n_in, out_size, ws_size); grid = -1; return; }
        int dev = 0, cus = 0, per_cu = 0;
        if (hipGetDevice(&dev) != hipSuccess || hipDeviceGetAttribute(&cus, hipDeviceAttributeMultiprocessorCount, dev) != hipSuccess) { grid = -1; return; }
        if (hipFuncSetAttribute((const void*)fwd_kernel, hipFuncAttributeMaxDynamicSharedMemorySize, LDS_BYTES) != hipSuccess) { fprintf(stderr, "kernel_launch: hipFuncSetAttribute failed\n"); grid = -1; return; }
        if (hipOccupancyMaxActiveBlocksPerMultiprocessor(&per_cu, (const void*)fwd_kernel, 512, LDS_BYTES) != hipSuccess || per_cu < 1) fprintf(stderr, "kernel_launch: occupancy query says %d blocks per CU\n", per_cu);
        (void)hipGetLastError();
        grid = cus;
    }
    if (grid < 0) return;
    Args a{};
    for (int i = 0; i < 28; ++i) a.in[i] = (const float*)d_in[i];
    a.out = (float*)d_out; a.ws = (unsigned char*)d_ws;
#if MK_MULTI
    for (int ph = 0; ph < NPH; ++ph) { a.ph_lo = ph; a.ph_hi = ph + 1; hipLaunchKernelGGL(fwd_kernel, dim3(grid), dim3(512), LDS_BYTES, stream, a); }
#else
    a.ph_lo = 0; a.ph_hi = NPH;
    void* kargs[] = {&a};
    const hipError_t e = hipLaunchCooperativeKernel((const void*)fwd_kernel, dim3(grid), dim3(512), kargs, LDS_BYTES, stream);
    if (e != hipSuccess) fprintf(stderr, "kernel_launch: cooperative launch failed: %s (grid %d)\n", hipGetErrorString(e), grid);
#endif
}
```
